# Optimizing an MI355X kernel written in HIP

```python
import math
import jax, jax.numpy as jnp
from jax import lax
import numpy as np

D_MODEL = 2048
BATCH = 4
SEQ = 2048
DEPTH = 1

N_META = 16
Q_BLOCK = 128
HEAD_DIM = 128
FOX_HEADS = 8
DIFF_HEADS = 4
DIFF_V_DIM = 2 * HEAD_DIM
FOX_WIDTH = FOX_HEADS * HEAD_DIM
DIFF_QK_WIDTH = DIFF_HEADS * 2 * HEAD_DIM
DIFF_WIDTH = DIFF_HEADS * DIFF_V_DIM
IN_SIZES = (FOX_WIDTH, FOX_WIDTH, FOX_WIDTH, FOX_HEADS,
            DIFF_QK_WIDTH, DIFF_QK_WIDTH, DIFF_WIDTH,
            D_MODEL, D_MODEL)
D_IN = 3 * FOX_WIDTH + FOX_HEADS + 2 * DIFF_QK_WIDTH + DIFF_WIDTH + 2 * D_MODEL
N_BUCKETS = 32
MAX_DISTANCE = 128
N_EXPERTS = 32
TOP_K = 4
D_EXPERT = D_MODEL
SWIGLU_LIMIT = 7.0
SWIGLU_ALPHA = 1.702
EXPERT_BLOCK = 128
RMS_EPS = 1e-5
NEG_INF = -1e30

kernel_name = "hybrid_fox_diffattn_gated_moe"


def rmsnorm(x, g):
    xf = x.astype(jnp.float32)
    y = xf * lax.rsqrt(jnp.mean(xf * xf, axis=-1, keepdims=True) + RMS_EPS) * g.astype(jnp.float32)
    return y.astype(x.dtype)


def split_heads(t, n_heads):
    b, l, _ = t.shape
    return t.reshape(b, l, n_heads, -1).transpose(0, 2, 1, 3)


def merge_heads(t):
    b, h, l, d = t.shape
    return t.transpose(0, 2, 1, 3).reshape(b, l, h * d)


def sweep_query_blocks(attend, total_len):
    meta = attend(0, N_META)
    n_blk = (total_len - N_META) // Q_BLOCK
    real = lax.map(lambda r: attend(N_META + r * Q_BLOCK, Q_BLOCK), jnp.arange(n_blk, dtype=jnp.int32))
    nb, b, h, qb, dv = real.shape
    real = jnp.moveaxis(real, 0, 2).reshape(b, h, nb * qb, dv)
    return jnp.concatenate([meta, real], axis=2)


def t5_bucket(dist):
    n = jnp.maximum(dist, 0)
    max_exact = N_BUCKETS // 2
    log_part = jnp.log(jnp.maximum(n, 1).astype(jnp.float32) / max_exact) / math.log(MAX_DISTANCE / max_exact)
    large = max_exact + (log_part * (N_BUCKETS - max_exact)).astype(jnp.int32)
    large = jnp.minimum(large, N_BUCKETS - 1)
    return jnp.where(n < max_exact, n, large)


def token_mixers(h, w_in, fox_forget_bias, lam_q1, lam_k1, lam_q2, lam_k2, diff_subln,
                 w_branch_fox, w_branch_diff, w_out, rel_bias_table, lambda_init):
    b, l, _ = h.shape
    proj = h @ w_in
    offs = np.cumsum(IN_SIZES)[:-1].tolist()
    fq, fk, fv, ff, dq, dk, dv, g_fox, g_diff = jnp.split(proj, offs, axis=-1)
    kpos = jnp.arange(l, dtype=jnp.int32)
    scale = HEAD_DIM ** -0.5

    fq, fk, fv = split_heads(fq, FOX_HEADS), split_heads(fk, FOX_HEADS), split_heads(fv, FOX_HEADS)
    log_f = jax.nn.log_sigmoid(ff.astype(jnp.float32) + fox_forget_bias.astype(jnp.float32))
    cum = jnp.cumsum(log_f, axis=1).transpose(0, 2, 1)

    def fox_block(start, size):
        q = lax.dynamic_slice_in_dim(fq, start, size, axis=2)
        cq = lax.dynamic_slice_in_dim(cum, start, size, axis=2)
        qpos = start + jnp.arange(size, dtype=jnp.int32)
        s = jnp.einsum('bhqd,bhkd->bhqk', q, fk).astype(jnp.float32) * scale
        s = s + (cq[..., :, None] - cum[..., None, :])
        s = jnp.where(kpos[None, :] <= qpos[:, None], s, NEG_INF)
        p = jax.nn.softmax(s, axis=-1).astype(fv.dtype)
        return jnp.einsum('bhqk,bhkd->bhqd', p, fv)

    o_fox = merge_heads(sweep_query_blocks(fox_block, l))

    dq = dq.reshape(b, l, DIFF_HEADS, 2, HEAD_DIM).transpose(3, 0, 2, 1, 4)
    dk = dk.reshape(b, l, DIFF_HEADS, 2, HEAD_DIM).transpose(3, 0, 2, 1, 4)
    dq1, dq2, dk1, dk2 = dq[0], dq[1], dk[0], dk[1]
    dv = split_heads(dv, DIFF_HEADS)
    lam = (jnp.exp(jnp.sum(lam_q1.astype(jnp.float32) * lam_k1.astype(jnp.float32)))
           - jnp.exp(jnp.sum(lam_q2.astype(jnp.float32) * lam_k2.astype(jnp.float32)))
           + lambda_init)

    def diff_block(start, size):
        q1 = lax.dynamic_slice_in_dim(dq1, start, size, axis=2)
        q2 = lax.dynamic_slice_in_dim(dq2, start, size, axis=2)
        qpos = start + jnp.arange(size, dtype=jnp.int32)
        bucket = t5_bucket(qpos[:, None] - kpos[None, :])
        bias = rel_bias_table[bucket].transpose(2, 0, 1).astype(jnp.float32)
        mask = kpos[None, :] <= qpos[:, None]
        s1 = jnp.einsum('bhqd,bhkd->bhqk', q1, dk1).astype(jnp.float32) * scale + bias
        s2 = jnp.einsum('bhqd,bhkd->bhqk', q2, dk2).astype(jnp.float32) * scale + bias
        p = (jax.nn.softmax(jnp.where(mask, s1, NEG_INF), axis=-1)
             - lam * jax.nn.softmax(jnp.where(mask, s2, NEG_INF), axis=-1))
        return jnp.einsum('bhqk,bhkd->bhqd', p.astype(dv.dtype), dv)

    o_diff = sweep_query_blocks(diff_block, l)
    o_diff = merge_heads(rmsnorm(o_diff, diff_subln) * (1.0 - lambda_init))

    merged = (jax.nn.sigmoid(g_fox) * (o_fox @ w_branch_fox)
              + jax.nn.sigmoid(g_diff) * (o_diff @ w_branch_diff))
    return merged @ w_out


def moe_ffn(h2d, w_router, b_router, w_gate_up, b_gate_up, w_down, b_down):
    n, d = h2d.shape
    logits = (h2d @ w_router + b_router).astype(jnp.float32)
    top_vals, top_idx = lax.top_k(logits, TOP_K)
    gates = jax.nn.softmax(top_vals, axis=-1)
    n_assign = n * TOP_K
    expert_flat = top_idx.reshape(-1)
    token_flat = jnp.arange(n_assign, dtype=jnp.int32) // TOP_K
    gate_flat = gates.reshape(-1)
    order = jnp.argsort(expert_flat, stable=True)
    sorted_expert = expert_flat[order]
    counts = jnp.zeros((N_EXPERTS,), jnp.int32).at[expert_flat].add(1)
    padded = ((counts + EXPERT_BLOCK - 1) // EXPERT_BLOCK) * EXPERT_BLOCK
    starts = jnp.cumsum(counts) - counts
    pends = jnp.cumsum(padded)
    pstarts = pends - padded
    dest = pstarts[sorted_expert] + (jnp.arange(n_assign, dtype=jnp.int32) - starts[sorted_expert])
    n_rows = (-(-n_assign // EXPERT_BLOCK)) * EXPERT_BLOCK + N_EXPERTS * EXPERT_BLOCK
    n_blk = n_rows // EXPERT_BLOCK
    row_token = jnp.zeros((n_rows,), jnp.int32).at[dest].set(token_flat[order])
    row_gate = jnp.zeros((n_rows,), jnp.float32).at[dest].set(gate_flat[order])
    block_start = jnp.arange(n_blk, dtype=jnp.int32) * EXPERT_BLOCK
    block_expert = jnp.minimum(jnp.sum(block_start[:, None] >= pends[None, :], axis=1), N_EXPERTS - 1)
    xs = h2d[row_token].reshape(n_blk, EXPERT_BLOCK, d)

    def expert_block(args):
        xb, e = args
        gu = xb @ w_gate_up[e] + b_gate_up[e]
        x_glu, x_lin = gu[:, :D_EXPERT], gu[:, D_EXPERT:]
        x_glu = jnp.minimum(x_glu, SWIGLU_LIMIT)
        x_lin = jnp.clip(x_lin, -SWIGLU_LIMIT, SWIGLU_LIMIT)
        act = x_glu * jax.nn.sigmoid(SWIGLU_ALPHA * x_glu) * (x_lin + 1.0)
        return act @ w_down[e] + b_down[e]

    ys = lax.map(expert_block, (xs, block_expert)).reshape(n_rows, d)
    return jnp.zeros_like(h2d).at[row_token].add(ys * row_gate[:, None].astype(ys.dtype))


def setup_inputs(seed: int = 0) -> dict:
    key = jax.random.key(seed)
    ks = jax.random.split(key, 24)
    nrm = jax.random.normal
    f32 = jnp.float32
    L = DEPTH
    return {
        "x": nrm(ks[0], (BATCH, SEQ, D_MODEL), f32),
        "meta_tokens": nrm(ks[1], (N_META, D_MODEL), f32),
        "rel_bias_table": 0.5 * nrm(ks[2], (N_BUCKETS, DIFF_HEADS), f32),
        "attn_norm": 1.0 + 0.02 * nrm(ks[3], (L, D_MODEL), f32),
        "w_in": nrm(ks[4], (L, D_MODEL, D_IN), f32) * D_MODEL ** -0.5,
        "fox_forget_bias": jnp.linspace(1.0, 6.0, FOX_HEADS, dtype=f32)[None, :] + 0.1 * nrm(ks[5], (L, FOX_HEADS), f32),
        "lam_q1": 0.1 * nrm(ks[6], (L, HEAD_DIM), f32),
        "lam_k1": 0.1 * nrm(ks[7], (L, HEAD_DIM), f32),
        "lam_q2": 0.1 * nrm(ks[8], (L, HEAD_DIM), f32),
        "lam_k2": 0.1 * nrm(ks[9], (L, HEAD_DIM), f32),
        "diff_subln": 1.0 + 0.02 * nrm(ks[10], (L, DIFF_V_DIM), f32),
        "w_branch_fox": nrm(ks[11], (L, FOX_WIDTH, D_MODEL), f32) * FOX_WIDTH ** -0.5,
        "w_branch_diff": nrm(ks[12], (L, DIFF_WIDTH, D_MODEL), f32) * DIFF_WIDTH ** -0.5,
        "w_out": nrm(ks[13], (L, D_MODEL, D_MODEL), f32) * D_MODEL ** -0.5,
        "ffn_norm": 1.0 + 0.02 * nrm(ks[14], (L, D_MODEL), f32),
        "w_router": nrm(ks[15], (L, D_MODEL, N_EXPERTS), f32) * D_MODEL ** -0.5,
        "b_router": 0.01 * nrm(ks[16], (L, N_EXPERTS), f32),
        "w_gate_up": nrm(ks[17], (L, N_EXPERTS, D_MODEL, 2 * D_EXPERT), f32) * D_MODEL ** -0.5,
        "b_gate_up": 0.01 * nrm(ks[18], (L, N_EXPERTS, 2 * D_EXPERT), f32),
        "w_down": nrm(ks[19], (L, N_EXPERTS, D_EXPERT, D_MODEL), f32) * D_EXPERT ** -0.5,
        "b_down": 0.01 * nrm(ks[20], (L, N_EXPERTS, D_MODEL), f32),
        "final_norm": 1.0 + 0.02 * nrm(ks[21], (D_MODEL,), f32),
    }


def reference(x, meta_tokens, rel_bias_table, attn_norm, w_in, fox_forget_bias,
              lam_q1, lam_k1, lam_q2, lam_k2, diff_subln, w_branch_fox, w_branch_diff, w_out,
              ffn_norm, w_router, b_router, w_gate_up, b_gate_up, w_down, b_down, final_norm):
    b = x.shape[0]
    meta = jnp.broadcast_to(meta_tokens.astype(x.dtype)[None], (b, N_META, x.shape[-1]))
    h_res = jnp.concatenate([meta, x], axis=1)
    total = h_res.shape[1]
    for layer in range(DEPTH):
        lambda_init = 0.8 - 0.6 * math.exp(-0.3 * layer)
        hn = rmsnorm(h_res, attn_norm[layer])
        h_res = h_res + token_mixers(hn, w_in[layer], fox_forget_bias[layer],
                                     lam_q1[layer], lam_k1[layer], lam_q2[layer], lam_k2[layer],
                                     diff_subln[layer], w_branch_fox[layer], w_branch_diff[layer],
                                     w_out[layer], rel_bias_table, lambda_init)
        hn = rmsnorm(h_res, ffn_norm[layer])
        ffn = moe_ffn(hn.reshape(b * total, -1), w_router[layer], b_router[layer],
                      w_gate_up[layer], b_gate_up[layer], w_down[layer], b_down[layer])
        h_res = h_res + ffn.reshape(b, total, -1)
    return rmsnorm(h_res, final_norm)[:, N_META:, :]
```

```cpp
#include <hip/hip_runtime.h>
#include <cstdio>
#include <cstdint>
namespace pg8 {
#define PG8_LAS __attribute__((address_space(3)))
typedef unsigned short bf16_t;
typedef short bf16x8 __attribute__((ext_vector_type(8)));
typedef float f32x4 __attribute__((ext_vector_type(4)));
typedef unsigned u32x4 __attribute__((ext_vector_type(4)));
typedef int v4i32 __attribute__((ext_vector_type(4)));
typedef int v8i32 __attribute__((ext_vector_type(8)));
constexpr int BM = 256, BK = 64, HALF = 128, HTB = HALF * BK * 2  , STAGE_BYTES = 8 * HTB, NXCD = 8, WGM = 8;

__host__ __device__ __forceinline__ int lds_byte(int r, int c) { const int st = (r >> 4) * 2 + (c >> 5), rr = r & 15, cc = c & 31, ob = rr * 64 + cc * 2; return st * 1024 + (ob ^ (((ob >> 9) & 1) << 5)); }
__host__ __device__ __forceinline__ void stage_rc(int b, int& R, int& C) { const int st = b / 1024, sb = b % 1024, swz = sb ^ (((sb >> 9) & 1) << 5); R = (st >> 1) * 16 + swz / 64; C = (st & 1) * 32 + (swz % 64) / 2; }
__host__ __device__ __forceinline__ int perm32(int rho) { const int n = rho >> 4, i = rho & 15; return 8 * (i >> 2) + 4 * n + (i & 3); }

struct Unit { int pm, pn, half; };
struct Gemm { const bf16_t* A; const bf16_t* Bt; int M, N, K; };

struct StaticOrder {
    int nM, nN, nwg, G, c;
    __host__ __device__ void init(int M, int N, int G_, int c_) { nM = M / BM; nN = N / BM; nwg = nM * nN; G = G_; c = c_; }
    __host__ __device__ bool next(int i, Unit& u) const {
        const long L = (long)i * G + c; if (L >= nwg) return false;
        int wgid = (int)L; { const int q = nwg / NXCD, r = nwg % NXCD, xcd = wgid % NXCD, off = wgid / NXCD; wgid = (xcd < r ? xcd * (q + 1) : r * (q + 1) + (xcd - r) * q) + off; }
        const int nig = WGM * nN, gid = wgid / nig, fm = gid * WGM, gsz = (nM - fm) < WGM ? (nM - fm) : WGM;
        u.pm = fm + ((wgid % nig) % gsz); u.pn = (wgid % nig) / gsz; u.half = 0; return true;
    }
    __device__ __forceinline__ void a_ready(const Unit&) const {}
    __device__ __forceinline__ void done(const Unit&) const {}
};

__device__ __forceinline__ unsigned cvt_pk_bf16(float lo, float hi) { unsigned r; asm volatile("v_cvt_pk_bf16_f32 %0, %1, %2" : "=v"(r) : "v"(lo), "v"(hi)); return r; }
typedef float f32x2 __attribute__((ext_vector_type(2)));
typedef unsigned u32x2 __attribute__((ext_vector_type(2)));
__device__ __forceinline__ float bf_lo(unsigned w) { return __uint_as_float(w << 16); }
__device__ __forceinline__ float bf_hi(unsigned w) { return __uint_as_float(w & 0xffff0000u); }
__device__ __forceinline__ float sigm(float x) { return __builtin_amdgcn_rcpf(1.0f + __builtin_amdgcn_exp2f(-1.4426950408889634f * x)); }
__device__ __forceinline__ u32x4 pack8(const f32x4& a, const f32x4& b) { u32x4 w; w.x = cvt_pk_bf16(a[0], a[1]); w.y = cvt_pk_bf16(a[2], a[3]); w.z = cvt_pk_bf16(b[0], b[1]); w.w = cvt_pk_bf16(b[2], b[3]); return w; }

__device__ __forceinline__ unsigned pk4_fp8(float a, float b, float c, float d) { unsigned w = __builtin_amdgcn_cvt_pk_fp8_f32(a, b, 0u, false); return __builtin_amdgcn_cvt_pk_fp8_f32(c, d, w, true); }
constexpr float W8_SCALE = 64.0f, X8_SCALE = 8.0f, A8_SCALE = 4.0f, Y8_SCALE = 32.0f;

struct EpiInProj {
    static constexpr bool PERM = true, AFTER_DRAIN = false;
    bf16_t *Qf, *Kf, *Vf, *Qd, *Kd, *Vd, *Gf, *Gd; float qscale;
    __device__ __forceinline__ void operator()(const f32x4 (&acc)[2][2][4][2], const Unit& u, int wr, int wc, int fr, int fq) const {
        const int colt = u.pn * BM, seg = colt >> 10;
        bf16_t* base; int ldc, col, rowoff = 0; float sc = 1.f; bool sg = false;
        const int kvoff = 64 * ((u.pm >> 3) + 1);
        if (seg < 6) { ldc = 1024; col = colt & 1023;
            if (seg == 0) { base = Qf; sc = qscale; } else if (seg == 1) { base = Kf; rowoff = kvoff; } else if (seg == 2) { base = Vf; rowoff = kvoff; }
            else if (seg == 3) { base = Qd; sc = qscale; } else if (seg == 4) { base = Kd; rowoff = kvoff; } else { base = Vd; rowoff = kvoff; } }
        else { ldc = 2048; sg = true; if (seg < 8) { base = Gf; col = colt - 6144; } else { base = Gd; col = colt - 8192; } }
        const int row0 = u.pm * BM + rowoff + wr * 64 + fr, col0 = col + wc * 32 + 8 * fq;
#pragma unroll
        for (int ai = 0; ai < 2; ++ai)
#pragma unroll
            for (int m = 0; m < 4; ++m) { bf16_t* rowp = base + (size_t)(row0 + ai * HALF + m * 16) * ldc + col0;
#pragma unroll
                for (int bj = 0; bj < 2; ++bj) { f32x4 v0 = acc[ai][bj][m][0], v1 = acc[ai][bj][m][1];
                    if (sg) {
#pragma unroll
                        for (int j = 0; j < 4; ++j) { v0[j] = sigm(v0[j]); v1[j] = sigm(v1[j]); } }
                    else { v0 = v0 * sc; v1 = v1 * sc; }
                    *(u32x4*)(rowp + bj * HALF) = pack8(v0, v1); } }
    }
};
struct EpiGate2 {
    static constexpr bool PERM = true, AFTER_DRAIN = false;
    const bf16_t* Gf; const bf16_t* Gd; bf16_t* T1; bf16_t* O;
    __device__ __forceinline__ void operator()(const f32x4 (&acc)[2][2][4][2], const Unit& u, int wr, int wc, int fr, int fq) const {
        const bool second = u.pm >= 32; const int pm = second ? u.pm - 32 : u.pm, pn = second ? u.pn - 8 : u.pn;
        const bf16_t* G = second ? Gd : Gf; bf16_t* out = second ? O : T1;
        const int row0 = pm * BM + wr * 64 + fr, col0 = pn * BM + wc * 32 + 8 * fq;
#pragma unroll
        for (int ai = 0; ai < 2; ++ai)
#pragma unroll
            for (int m = 0; m < 4; ++m) { const size_t off = (size_t)(row0 + ai * HALF + m * 16) * 2048 + col0;
#pragma unroll
                for (int bj = 0; bj < 2; ++bj) { f32x4 v0 = acc[ai][bj][m][0], v1 = acc[ai][bj][m][1];
                    const u32x4 g = *(const u32x4*)(G + off + bj * HALF);
                    v0[0] *= bf_lo(g.x); v0[1] *= bf_hi(g.x); v0[2] *= bf_lo(g.y); v0[3] *= bf_hi(g.y); v1[0] *= bf_lo(g.z); v1[1] *= bf_hi(g.z); v1[2] *= bf_lo(g.w); v1[3] *= bf_hi(g.w);
                    if (second) { const u32x4 t = *(const u32x4*)(T1 + off + bj * HALF);
                        v0[0] += bf_lo(t.x); v0[1] += bf_hi(t.x); v0[2] += bf_lo(t.y); v0[3] += bf_hi(t.y); v1[0] += bf_lo(t.z); v1[1] += bf_hi(t.z); v1[2] += bf_lo(t.w); v1[3] += bf_hi(t.w); }
                    *(u32x4*)(out + off + bj * HALF) = pack8(v0, v1); } }
    }
};
struct PairOrder {
    StaticOrder S;
    __device__ __forceinline__ bool next(int i, Unit& u) const { if (!S.next(i >> 1, u)) return false; if (i & 1) { u.pm += 32; u.pn += 8; } return true; }
    __device__ __forceinline__ void a_ready(const Unit&) const {}
    __device__ __forceinline__ void done(const Unit&) const {}
};
struct EpiResF32 {
    static constexpr bool PERM = false, AFTER_DRAIN = false;
    const float* X; float* C;
    __device__ __forceinline__ void operator()(const f32x4 (&acc)[2][2][4][2], const Unit& u, int wr, int wc, int fr, int fq) const {
        const int row0 = u.pm * BM + wr * 64 + fr, col0 = u.pn * BM + wc * 32 + 4 * fq;
#pragma unroll
        for (int ai = 0; ai < 2; ++ai)
#pragma unroll
            for (int m = 0; m < 4; ++m) { const size_t off = (size_t)(row0 + ai * HALF + m * 16) * 2048 + col0;
#pragma unroll
                for (int bj = 0; bj < 2; ++bj)
#pragma unroll
                    for (int n = 0; n < 2; ++n) { const f32x4 xv = *(const f32x4*)(X + off + bj * HALF + n * 16); *(f32x4*)(C + off + bj * HALF + n * 16) = acc[ai][bj][m][n] + xv; } }
    }
};
struct EpiSwiglu {
    static constexpr bool PERM = true, AFTER_DRAIN = false;
    const float* bgu; unsigned char* ACT;
    __device__ __forceinline__ void operator()(const f32x4 (&acc)[2][2][4][2], const Unit& u, int wr, int wc, int fr, int fq) const {
        const int e = u.pn >> 4, j = u.pn & 15;
        const int row0 = u.pm * HALF + wr * 64 + fr, cl = j * HALF + wc * 32 + 8 * fq;
        const float* bg = bgu + (size_t)e * 4096 + cl;
        const f32x4 bg0 = *(const f32x4*)(bg), bg1 = *(const f32x4*)(bg + 4), bl0 = *(const f32x4*)(bg + 2048), bl1 = *(const f32x4*)(bg + 2048 + 4);
        const float isc = 1.0f / (W8_SCALE * X8_SCALE);
#pragma unroll
        for (int ai = 0; ai < 2; ++ai) { if (ai == 1 && u.half) break;
#pragma unroll
            for (int m = 0; m < 4; ++m) {
                f32x4 g0 = acc[ai][0][m][0] * isc + bg0, g1 = acc[ai][0][m][1] * isc + bg1, l0 = acc[ai][1][m][0] * isc + bl0, l1 = acc[ai][1][m][1] * isc + bl1, a0, a1;
#pragma unroll
                for (int i = 0; i < 4; ++i) {
                    float xg = fminf(g0[i], 7.0f), xl = fminf(fmaxf(l0[i], -7.0f), 7.0f); a0[i] = xg * sigm(1.702f * xg) * (xl + 1.0f) * A8_SCALE;
                    xg = fminf(g1[i], 7.0f); xl = fminf(fmaxf(l1[i], -7.0f), 7.0f); a1[i] = xg * sigm(1.702f * xg) * (xl + 1.0f) * A8_SCALE; }
                u32x2 w; w.x = pk4_fp8(a0[0], a0[1], a0[2], a0[3]); w.y = pk4_fp8(a1[0], a1[1], a1[2], a1[3]);
                *(u32x2*)(ACT + (size_t)(row0 + ai * HALF + m * 16) * 2048 + cl) = w; } }
    }
};
struct EpiDown {
    static constexpr bool PERM = true, AFTER_DRAIN = false;
    const float* bd; unsigned char* YS;
    __device__ __forceinline__ void operator()(const f32x4 (&acc)[2][2][4][2], const Unit& u, int wr, int wc, int fr, int fq) const {
        const int j = u.pn & 7;
        const int row0 = u.pm * HALF + wr * 64 + fr, col0 = j * BM + wc * 32 + 8 * fq;
        const float* bp = bd + (size_t)u.pn * BM + wc * 32 + 8 * fq;
        const float isc = 1.0f / (W8_SCALE * A8_SCALE);
        f32x4 bv[2][2];
#pragma unroll
        for (int bj = 0; bj < 2; ++bj)
#pragma unroll
            for (int n = 0; n < 2; ++n) bv[bj][n] = *(const f32x4*)(bp + bj * HALF + 4 * n);
#pragma unroll
        for (int ai = 0; ai < 2; ++ai) { if (ai == 1 && u.half) break;
#pragma unroll
            for (int m = 0; m < 4; ++m) { unsigned char* rowp = YS + (size_t)(row0 + ai * HALF + m * 16) * 2048 + col0;
#pragma unroll
                for (int bj = 0; bj < 2; ++bj) { const f32x4 y0 = (acc[ai][bj][m][0] * isc + bv[bj][0]) * Y8_SCALE, y1 = (acc[ai][bj][m][1] * isc + bv[bj][1]) * Y8_SCALE;
                    u32x2 w; w.x = pk4_fp8(y0[0], y0[1], y0[2], y0[3]); w.y = pk4_fp8(y1[0], y1[1], y1[2], y1[3]); *(u32x2*)(rowp + bj * HALF) = w; } } }
    }
};
struct ListOrder {
    const PG8_LAS int* list; int n; const PG8_LAS int* tokl;
    __device__ __forceinline__ bool next(int i, Unit& u) const { if (i >= n) return false; u.pm = __builtin_amdgcn_readfirstlane(list[2 * i]); const int w = __builtin_amdgcn_readfirstlane(list[2 * i + 1]); u.pn = w & 0xffff; u.half = w >> 16; return true; }
    __device__ __forceinline__ void a_ready(const Unit&) const {}
    __device__ __forceinline__ void done(const Unit&) const {}
};
struct BgW { const float* w_gu; const float* w_dn; unsigned char* wgu8; unsigned char* wd8; int pos, end, G, pend; float scale; int split, skip; };
constexpr int BGW_GU = 32 * 1024, BGW_ALL = BGW_GU + 32 * 512;
__device__ __forceinline__ void bgw_glds16(const void* gsrc, unsigned lds_dst) { unsigned keep;
    asm volatile("s_mov_b32 %0, m0\n\ts_mov_b32 m0, %2\n\ts_nop 0\n\tglobal_load_lds_dwordx4 %1, off\n\ts_mov_b32 m0, %0" : "=&s"(keep) : "v"(gsrc), "s"(lds_dst) : "memory"); }
__device__ __forceinline__ void bgw_glds16s(const float* sbase, unsigned voff, unsigned lds_dst) { unsigned keep;
    asm volatile("s_mov_b32 %0, m0\n\ts_mov_b32 m0, %3\n\ts_nop 0\n\tglobal_load_lds_dwordx4 %1, %2\n\ts_mov_b32 m0, %0" : "=&s"(keep) : "v"(voff), "s"(sbase), "s"(lds_dst) : "memory"); }
__device__ __forceinline__ void bgw_addr(const BgW& b, int j_, int wid, const float*& src, unsigned char*& dst, int& ldw) {
    const int idx = j_ < b.split ? j_ : j_ + b.skip;
    if (idx < BGW_GU) { const int e = idx >> 10, r = idx & 1023, n64 = r & 63, kb = r >> 6, nb = 64 * n64 + 8 * wid;
        const int drow = nb < 2048 ? 256 * (nb >> 7) + (nb & 127) : 256 * ((nb - 2048) >> 7) + 128 + (nb & 127);
        ldw = 4096; src = b.w_gu + (size_t)e * 2048 * 4096 + (size_t)(128 * kb) * 4096 + nb; dst = b.wgu8 + (size_t)e * 4096 * 2048 + (size_t)drow * 2048 + 128 * kb; }
    else { const int j = idx - BGW_GU, e = j >> 9, r = j & 511, n64 = r & 31, kb = r >> 5, nb = 64 * n64 + 8 * wid;
        ldw = 2048; src = b.w_dn + (size_t)e * 2048 * 2048 + (size_t)(128 * kb) * 2048 + nb; dst = b.wd8 + (size_t)e * 2048 * 2048 + (size_t)nb * 2048 + 128 * kb; }
}
__device__ __forceinline__ void bgw_issue2(const BgW& b, int idx, unsigned slot, int wid, int lane, int h) {
    asm volatile("" : "+v"(lane));
    const float* src; unsigned char* dst; int ldw; bgw_addr(b, idx, wid, src, dst, ldw);
    const unsigned rl = (unsigned)(lane >> 1);
#pragma unroll
    for (int p = 0; p < 2; ++p) { const int pc = 2 * h + p; const unsigned kl = rl ^ ((rl >> 4) & 1u) ^ (2u * (unsigned)(pc & 1));
        bgw_glds16s(src + (size_t)(32 * pc) * ldw, (kl * (unsigned)ldw + 4u * (unsigned)(lane & 1)) * 4u, (unsigned)__builtin_amdgcn_readfirstlane(slot + pc * 1024)); }
}
__device__ __forceinline__ void bgw_cload(float (&v)[16], const PG8_LAS float* sl, int lane) {
    const int kq = lane >> 3, x = (kq & 1) ^ (2 * ((kq >> 1) & 1));
    const PG8_LAS float* p = sl + (kq >> 1) * 256 + (16 * (kq & 1)) * 8 + (lane & 7);
    const PG8_LAS float* p0 = p + (0 ^ x) * 8; const PG8_LAS float* p1 = p + (1 ^ x) * 8; const PG8_LAS float* p2 = p + (2 ^ x) * 8; const PG8_LAS float* p3 = p + (3 ^ x) * 8;
#pragma unroll
    for (int q = 0; q < 4; ++q) { v[4 * q + 0] = p0[32 * q]; v[4 * q + 1] = p1[32 * q]; v[4 * q + 2] = p2[32 * q]; v[4 * q + 3] = p3[32 * q]; }
}
__device__ __forceinline__ void bgw_cstore(const BgW& b, int idx, const float (&v)[16], int wid, int lane) {
    const float* src; unsigned char* dst; int ldw; bgw_addr(b, idx, wid, src, dst, ldw);
    const int n = lane & 7, kq = lane >> 3; const float sc = b.scale; u32x4 o;
    o.x = __builtin_amdgcn_cvt_pk_fp8_f32(v[2] * sc, v[3] * sc, __builtin_amdgcn_cvt_pk_fp8_f32(v[0] * sc, v[1] * sc, 0u, false), true);
    o.y = __builtin_amdgcn_cvt_pk_fp8_f32(v[6] * sc, v[7] * sc, __builtin_amdgcn_cvt_pk_fp8_f32(v[4] * sc, v[5] * sc, 0u, false), true);
    o.z = __builtin_amdgcn_cvt_pk_fp8_f32(v[10] * sc, v[11] * sc, __builtin_amdgcn_cvt_pk_fp8_f32(v[8] * sc, v[9] * sc, 0u, false), true);
    o.w = __builtin_amdgcn_cvt_pk_fp8_f32(v[14] * sc, v[15] * sc, __builtin_amdgcn_cvt_pk_fp8_f32(v[12] * sc, v[13] * sc, 0u, false), true);
    *(u32x4*)(dst + (size_t)n * 2048 + 16 * kq) = o;
}
__device__ __forceinline__ void bgw_st16(const BgW& b, int idx, u32x4 o, int wid, int lane) { const float* src; unsigned char* dst; int ldw; bgw_addr(b, idx, wid, src, dst, ldw); const unsigned off = (unsigned)(lane & 7) * 2048u + 16u * (unsigned)(lane >> 3); *(__attribute__((address_space(1))) u32x4*)((__attribute__((address_space(1))) unsigned char*)dst + off) = o; }
__device__ __forceinline__ void bgw_consume(const BgW& b, int idx, const PG8_LAS float* sl, int wid, int lane) {
    asm volatile("" : "+v"(lane));
    const int kq = lane >> 3, x = (kq & 1) ^ (2 * ((kq >> 1) & 1)); const float sc = b.scale;
    const PG8_LAS float* p = sl + (kq >> 1) * 256 + (16 * (kq & 1)) * 8 + (lane & 7);
    const PG8_LAS float* p0 = p + (0 ^ x) * 8; const PG8_LAS float* p1 = p + (1 ^ x) * 8; const PG8_LAS float* p2 = p + (2 ^ x) * 8; const PG8_LAS float* p3 = p + (3 ^ x) * 8;
    u32x4 o;
    { const float a0 = p0[0], a1 = p1[0], a2 = p2[0], a3 = p3[0], a4 = p0[32], a5 = p1[32], a6 = p2[32], a7 = p3[32];
      o.x = __builtin_amdgcn_cvt_pk_fp8_f32(a2 * sc, a3 * sc, __builtin_amdgcn_cvt_pk_fp8_f32(a0 * sc, a1 * sc, 0u, false), true);
      o.y = __builtin_amdgcn_cvt_pk_fp8_f32(a6 * sc, a7 * sc, __builtin_amdgcn_cvt_pk_fp8_f32(a4 * sc, a5 * sc, 0u, false), true); }
    asm volatile("" ::: "memory");
    { const float a0 = p0[64], a1 = p1[64], a2 = p2[64], a3 = p3[64], a4 = p0[96], a5 = p1[96], a6 = p2[96], a7 = p3[96];
      o.z = __builtin_amdgcn_cvt_pk_fp8_f32(a2 * sc, a3 * sc, __builtin_amdgcn_cvt_pk_fp8_f32(a0 * sc, a1 * sc, 0u, false), true);
      o.w = __builtin_amdgcn_cvt_pk_fp8_f32(a6 * sc, a7 * sc, __builtin_amdgcn_cvt_pk_fp8_f32(a4 * sc, a5 * sc, 0u, false), true); }
    bgw_st16(b, idx, o, wid, lane);
}
__device__ __forceinline__ f32x4 bgw_rd4(const PG8_LAS float* sl, int lane, int q) { const PG8_LAS float* p = sl + (16 * (lane >> 3) + 4 * q) * 8 + (lane & 7); f32x4 v; v.x = p[0]; v.y = p[8]; v.z = p[16]; v.w = p[24]; return v; }
__device__ __forceinline__ unsigned bgw_cvt4(f32x4 v, float sc) { return __builtin_amdgcn_cvt_pk_fp8_f32(v.z * sc, v.w * sc, __builtin_amdgcn_cvt_pk_fp8_f32(v.x * sc, v.y * sc, 0u, false), true); }
template <class Epi, class Sched, bool ALIGN_EPI = false, bool SP2 = false, bool F8 = false, int BGPM = -1, bool GATHER = false>
__device__ __forceinline__ void gemm_phase(PG8_LAS unsigned char* lds, const Gemm g, const Sched& S, const Epi& E, BgW* bg = nullptr) {
    constexpr bool BGON = BGPM >= 0;
    int tid_o = threadIdx.x; asm volatile("" : "+v"(tid_o));
    const int tid = tid_o, wid = __builtin_amdgcn_readfirstlane(tid >> 6), lane = tid & 63, wr = wid >> 2, wc = wid & 3, fr = lane & 15, fq = lane >> 4;
    const int K = g.K, nt = K / BK;
    unsigned voffA[2], voffB[2]; int gR[2]; unsigned gC[2];
#pragma unroll
    for (int i = 0; i < 2; ++i) { int R, C; stage_rc(tid * 16 + i * 8192, R, C); const int Rb = Epi::PERM ? ((R & ~31) + perm32(R & 31)) : R;
        voffA[i] = (unsigned)(R * K + C) * 2u; voffB[i] = (unsigned)(Rb * K + C) * 2u; gR[i] = R; gC[i] = (unsigned)C * 2u; }
    unsigned gc00 = 0, gc01 = 0, gc10 = 0, gc11 = 0, gn00 = 0, gn01 = 0, gn10 = 0, gn11 = 0;
    static_assert(!GATHER || SP2, "gather: SP2 schedule only");
    const size_t kstep = (size_t)(BK * 2);
    const size_t hstep = (size_t)HALF * K * 2;
    const size_t tstep = 2 * hstep;
    const size_t astep = F8 ? hstep : tstep;
    const unsigned ldsw = (unsigned)wid * 1024u;
    const int aoff = lds_byte(wr * 64 + fr, fq * 8), boff = lds_byte(wc * 32 + fr, fq * 8);
#define PG8_SA(b, h) (((b) * 2 + (h)) * HTB)
#define PG8_SB(b, h) ((4 + (b) * 2 + (h)) * HTB)
#define PG8_STAGE(bufoff, gbase, voff) do { _Pragma("unroll") for (int _i = 0; _i < 2; ++_i) \
        __builtin_amdgcn_global_load_lds((const unsigned*)((const char*)(gbase) + (voff)[_i]), (PG8_LAS unsigned*)(lds + (bufoff) + ldsw + _i * 8192), 16, 0, 0); } while (0)
#define PG8_STAGE_A(bufoff, gbase, h, NX) do { if constexpr (GATHER) { unsigned go_[2]; \
            if ((h) == 0) { go_[0] = ((NX) && last_) ? gn00 : gc00; go_[1] = ((NX) && last_) ? gn01 : gc01; } else { go_[0] = ((NX) && last_) ? gn10 : gc10; go_[1] = ((NX) && last_) ? gn11 : gc11; } \
            PG8_STAGE(bufoff, gbase, go_); } \
        else PG8_STAGE(bufoff, (const char*)(gbase) + (h) * hstep, voffA); } while (0)
#define PG8_LDA(dst, b, h) do { _Pragma("unroll") for (int m = 0; m < 4; ++m) _Pragma("unroll") for (int k = 0; k < 2; ++k) dst[m][k] = *(const PG8_LAS bf16x8*)(lds + PG8_SA(b, h) + aoff + m * 2048 + k * 1024); } while (0)
#define PG8_LDB(dst, b, h) do { _Pragma("unroll") for (int n = 0; n < 2; ++n) _Pragma("unroll") for (int k = 0; k < 2; ++k) dst[n][k] = *(const PG8_LAS bf16x8*)(lds + PG8_SB(b, h) + boff + n * 2048 + k * 1024); } while (0)
#define PG8_MMA(ai, bj, At, Bt) do { __builtin_amdgcn_s_setprio(1); \
        if constexpr (F8) { _Pragma("unroll") for (int m = 0; m < 4; ++m) _Pragma("unroll") for (int n = 0; n < 2; ++n) { \
            const v8i32 fa_ = __builtin_shufflevector(__builtin_bit_cast(v4i32, At[m][0]), __builtin_bit_cast(v4i32, At[m][1]), 0, 1, 2, 3, 4, 5, 6, 7); \
            const v8i32 fb_ = __builtin_shufflevector(__builtin_bit_cast(v4i32, Bt[n][0]), __builtin_bit_cast(v4i32, Bt[n][1]), 0, 1, 2, 3, 4, 5, 6, 7); \
            asm volatile("v_mfma_f32_16x16x128_f8f6f4 %0, %1, %2, %0" : "+v"(acc[ai][bj][m][n]) : "v"(fb_), "v"(fa_)); } } \
        else { _Pragma("unroll") for (int m = 0; m < 4; ++m) _Pragma("unroll") for (int n = 0; n < 2; ++n) _Pragma("unroll") for (int k = 0; k < 2; ++k) \
            acc[ai][bj][m][n] = __builtin_amdgcn_mfma_f32_16x16x32_bf16(Bt[n][k], At[m][k], acc[ai][bj][m][n], 0, 0, 0); } \
        __builtin_amdgcn_s_setprio(0); } while (0)
#define PG8_MMA_M(ai, bj, At, Bt, m0, m1) do { __builtin_amdgcn_s_setprio(1); \
        if constexpr (F8) { _Pragma("unroll") for (int m = m0; m < m1; ++m) _Pragma("unroll") for (int n = 0; n < 2; ++n) { \
            const v8i32 fa_ = __builtin_shufflevector(__builtin_bit_cast(v4i32, At[m][0]), __builtin_bit_cast(v4i32, At[m][1]), 0, 1, 2, 3, 4, 5, 6, 7); \
            const v8i32 fb_ = __builtin_shufflevector(__builtin_bit_cast(v4i32, Bt[n][0]), __builtin_bit_cast(v4i32, Bt[n][1]), 0, 1, 2, 3, 4, 5, 6, 7); \
            asm volatile("v_mfma_f32_16x16x128_f8f6f4 %0, %1, %2, %0" : "+v"(acc[ai][bj][m][n]) : "v"(fb_), "v"(fa_)); } } \
        else { _Pragma("unroll") for (int m = m0; m < m1; ++m) _Pragma("unroll") for (int n = 0; n < 2; ++n) _Pragma("unroll") for (int k = 0; k < 2; ++k) \
            acc[ai][bj][m][n] = __builtin_amdgcn_mfma_f32_16x16x32_bf16(Bt[n][k], At[m][k], acc[ai][bj][m][n], 0, 0, 0); } \
        __builtin_amdgcn_s_setprio(0); } while (0)
#define PG8_WAIT_V(n) asm volatile("s_waitcnt vmcnt(" #n ")" ::: "memory")
#define PG8_WAIT_L(n) asm volatile("s_waitcnt lgkmcnt(" #n ")" ::: "memory")
#define PG8_BAR __builtin_amdgcn_s_barrier()
#define PG8_SCHED __builtin_amdgcn_sched_barrier(0)
    int nbg = 0;
#define PG8_WAIT_V8N() do { if constexpr (BGON) { if (nbg == 5) PG8_WAIT_V(13); else if (nbg == 4) PG8_WAIT_V(12); else if (nbg == 1) PG8_WAIT_V(9); else PG8_WAIT_V(8); } else PG8_WAIT_V(8); } while (0)
    const unsigned bg_slot = (unsigned)(size_t)(lds + 131072 + wid * 4096); const PG8_LAS float* bg_sl = (const PG8_LAS float*)(lds + 131072 + wid * 4096);
#define PG8_MMA_BG(At, B0, B1) do { const bool iss_ = bg->pos < bg->end; const bool mm_ = !F8 || !cur.half; \
        if (mm_) { PG8_MMA(1, 0, At, B0); PG8_MMA_M(1, 1, At, B1, 0, 2); } \
        if (iss_) { asm volatile("s_waitcnt lgkmcnt(0)" ::: "memory"); bgw_issue2(*bg, bg->pos, bg_slot, wid, lane, 0); } \
        if (mm_) PG8_MMA_M(1, 1, At, B1, 2, 3); \
        if (iss_) { bgw_issue2(*bg, bg->pos, bg_slot, wid, lane, 1); bg->pend = bg->pos; bg->pos += bg->G; nbg += 4; } else bg->pend = -1; \
        if (mm_) PG8_MMA_M(1, 1, At, B1, 3, 4); } while (0)
    Unit cur, nxt; int ui = 0;
    if (!S.next(0, cur)) return;
    f32x4 acc[2][2][4][2];
#pragma unroll
    for (int a = 0; a < 2; ++a)
#pragma unroll
        for (int b = 0; b < 2; ++b)
#pragma unroll
            for (int m = 0; m < 4; ++m)
#pragma unroll
                for (int n = 0; n < 2; ++n) acc[a][b][m][n] = (f32x4){0.f, 0.f, 0.f, 0.f};
    bf16x8 At[4][2], B0[2][2], B1[2][2];
    const char* cA = GATHER ? (const char*)g.A : (const char*)g.A + (size_t)cur.pm * astep; const char* cB = (const char*)g.Bt + (size_t)cur.pn * tstep;
    if constexpr (GATHER) { const PG8_LAS int* tk = S.tokl; gc00 = (unsigned)tk[gR[0]] + gC[0]; gc01 = (unsigned)tk[gR[1]] + gC[1]; gc10 = (unsigned)tk[128 + gR[0]] + gC[0]; gc11 = (unsigned)tk[128 + gR[1]] + gC[1]; }
    bool last_ = false;
    S.a_ready(cur);
    if constexpr (SP2) {
        PG8_STAGE(PG8_SB(0, 0), cB, voffB); PG8_STAGE(PG8_SB(0, 1), cB + hstep, voffB); PG8_STAGE_A(PG8_SA(0, 0), cA, 0, false); PG8_STAGE_A(PG8_SA(0, 1), cA, 1, false);
        if (wr == 1) PG8_BAR;
        PG8_WAIT_V(2); PG8_BAR;
        PG8_STAGE(PG8_SB(1, 0), cB + kstep, voffB); PG8_STAGE_A(PG8_SA(1, 0), cA + kstep, 0, false); PG8_STAGE(PG8_SB(1, 1), cB + hstep + kstep, voffB);
        PG8_WAIT_V(6); PG8_BAR;
    } else {
        PG8_STAGE(PG8_SB(0, 0), cB, voffB); PG8_STAGE(PG8_SA(0, 0), cA, voffA); PG8_STAGE(PG8_SB(0, 1), cB + hstep, voffB); PG8_STAGE(PG8_SA(0, 1), cA + hstep, voffA);
        if (wr == 1) PG8_BAR;
        PG8_WAIT_V(4); PG8_BAR;
        PG8_STAGE(PG8_SB(1, 0), cB + kstep, voffB); PG8_STAGE(PG8_SA(1, 0), cA + kstep, voffA); PG8_STAGE(PG8_SB(1, 1), cB + hstep + kstep, voffB);
        PG8_WAIT_V(6); PG8_BAR;
    }
    for (;;) {
        const bool has_next = S.next(ui + 1, nxt);
        const char* nA = (GATHER || !has_next) ? cA : (const char*)g.A + (size_t)nxt.pm * astep; const char* nB = has_next ? (const char*)g.Bt + (size_t)nxt.pn * tstep : cB;
        if constexpr (GATHER) { if (has_next) { const PG8_LAS int* tk = S.tokl + 256 * (ui + 1); gn00 = (unsigned)tk[gR[0]] + gC[0]; gn01 = (unsigned)tk[gR[1]] + gC[1]; gn10 = (unsigned)tk[128 + gR[0]] + gC[0]; gn11 = (unsigned)tk[128 + gR[1]] + gC[1]; }
            else { gn00 = gc00; gn01 = gc01; gn10 = gc10; gn11 = gc11; } }
        for (int t = 0; t < nt; t += 2) {
            const bool last = (t == nt - 2); last_ = last;
            const char* a1 = cA + (size_t)(t + 1) * kstep;
            const char* a2 = last ? nA : cA + (size_t)(t + 2) * kstep; const char* b2 = last ? nB : cB + (size_t)(t + 2) * kstep;
            const char* a3 = a2 + kstep; const char* b3 = b2 + kstep;
            if (last && has_next) S.a_ready(nxt);
            if constexpr (SP2) {
            PG8_LDB(B0, 0, 0); PG8_LDB(B1, 0, 1); PG8_SCHED; PG8_LDA(At, 0, 0); PG8_STAGE_A(PG8_SA(1, 1), a1, 1, false);
            PG8_WAIT_V8N(); PG8_WAIT_L(0); PG8_BAR; PG8_MMA(0, 0, At, B0); PG8_MMA(0, 1, At, B1); PG8_BAR; PG8_SCHED;
            PG8_LDA(At, 0, 1); PG8_STAGE(PG8_SB(0, 0), b2, voffB); PG8_STAGE(PG8_SB(0, 1), b2 + hstep, voffB); PG8_STAGE_A(PG8_SA(0, 0), a2, 0, true);
            PG8_WAIT_V8N(); nbg = 0;
            PG8_WAIT_L(0); PG8_BAR; if (!F8 || !cur.half) { PG8_MMA(1, 0, At, B0); PG8_MMA(1, 1, At, B1); } PG8_BAR; PG8_SCHED;
            PG8_LDB(B0, 1, 0); PG8_LDB(B1, 1, 1); PG8_SCHED; PG8_LDA(At, 1, 0); PG8_STAGE_A(PG8_SA(0, 1), a2, 1, true);
            PG8_WAIT_V(8); PG8_WAIT_L(0); PG8_BAR; PG8_MMA(0, 0, At, B0); PG8_MMA(0, 1, At, B1); PG8_BAR; PG8_SCHED;
            PG8_LDA(At, 1, 1); PG8_STAGE(PG8_SB(1, 0), b3, voffB); PG8_STAGE(PG8_SB(1, 1), b3 + hstep, voffB); PG8_STAGE_A(PG8_SA(1, 0), a3, 0, true);
            PG8_WAIT_V(8); PG8_WAIT_L(0);
            if constexpr (BGON) { if ((t & BGPM) == 0 && bg->pend >= 0) { bgw_consume(*bg, bg->pend, bg_sl, wid, lane); nbg = 1; } }
            PG8_BAR;
            if constexpr (BGON) { if ((t & BGPM) == 0) PG8_MMA_BG(At, B0, B1); else if (!F8 || !cur.half) { PG8_MMA(1, 0, At, B0); PG8_MMA(1, 1, At, B1); } }
            else { if (!F8 || !cur.half) { PG8_MMA(1, 0, At, B0); PG8_MMA(1, 1, At, B1); } }
            PG8_BAR; PG8_SCHED;
            } else {
            PG8_LDB(B0, 0, 0); PG8_SCHED; PG8_LDA(At, 0, 0); PG8_STAGE(PG8_SA(1, 1), a1 + hstep, voffA);
            PG8_WAIT_L(8); PG8_BAR; PG8_WAIT_L(0); PG8_MMA(0, 0, At, B0); PG8_BAR; PG8_SCHED;
            PG8_LDB(B1, 0, 1); PG8_STAGE(PG8_SB(0, 0), b2, voffB);
            PG8_BAR; PG8_WAIT_L(0); PG8_MMA(0, 1, At, B1); PG8_BAR;
            PG8_LDA(At, 0, 1); PG8_STAGE(PG8_SA(0, 0), a2, voffA);
            PG8_BAR; PG8_WAIT_L(0); PG8_MMA(1, 0, At, B0); PG8_BAR; PG8_SCHED;
            PG8_STAGE(PG8_SB(0, 1), b2 + hstep, voffB);
            PG8_WAIT_V(6); PG8_BAR; PG8_MMA(1, 1, At, B1); PG8_BAR;
            PG8_LDB(B0, 1, 0); PG8_SCHED; PG8_LDA(At, 1, 0); PG8_STAGE(PG8_SA(0, 1), a2 + hstep, voffA);
            PG8_WAIT_L(8); PG8_BAR; PG8_WAIT_L(0); PG8_MMA(0, 0, At, B0); PG8_BAR; PG8_SCHED;
            PG8_LDB(B1, 1, 1); PG8_STAGE(PG8_SB(1, 0), b3, voffB);
            PG8_BAR; PG8_WAIT_L(0); PG8_MMA(0, 1, At, B1); PG8_BAR;
            PG8_LDA(At, 1, 1); PG8_STAGE(PG8_SA(1, 0), a3, voffA);
            PG8_BAR; PG8_WAIT_L(0); PG8_MMA(1, 0, At, B0); PG8_BAR; PG8_SCHED;
            PG8_STAGE(PG8_SB(1, 1), b3 + hstep, voffB);
            PG8_WAIT_V(6); PG8_BAR; PG8_MMA(1, 1, At, B1); PG8_BAR;
            }
        }
        if constexpr (ALIGN_EPI) { if (wr == 0) PG8_BAR; }
        if constexpr (F8) asm volatile("s_nop 15\n\ts_nop 7" ::: "memory");
        if constexpr (!Epi::AFTER_DRAIN) { E(acc, cur, wr, wc, fr, fq); S.done(cur); }
        if (!has_next) break;
#pragma unroll
        for (int a = 0; a < 2; ++a)
#pragma unroll
            for (int b = 0; b < 2; ++b)
#pragma unroll
                for (int m = 0; m < 4; ++m)
#pragma unroll
                    for (int n = 0; n < 2; ++n) acc[a][b][m][n] = (f32x4){0.f, 0.f, 0.f, 0.f};
        cur = nxt; cA = nA; cB = nB; ++ui;
        if constexpr (GATHER) { gc00 = gn00; gc01 = gn01; gc10 = gn10; gc11 = gn11; }
        if constexpr (ALIGN_EPI) { if (wr == 1) PG8_BAR; }
    }
    PG8_WAIT_V(0);
    if constexpr (!ALIGN_EPI) { if (wr == 0) PG8_BAR; }
    PG8_BAR;
    if constexpr (Epi::AFTER_DRAIN) { E.fused(acc, cur, wr, wc, fr, fq, lds, wid, lane); S.done(cur); }
    if constexpr (BGON) {
        if (bg->pend >= 0) bgw_consume(*bg, bg->pend, bg_sl, wid, lane);
        while (bg->pos < bg->end) { asm volatile("s_waitcnt lgkmcnt(0)" ::: "memory"); bgw_issue2(*bg, bg->pos, bg_slot, wid, lane, 0); bgw_issue2(*bg, bg->pos, bg_slot, wid, lane, 1); asm volatile("s_waitcnt vmcnt(0)" ::: "memory"); bgw_consume(*bg, bg->pos, bg_sl, wid, lane); bg->pos += bg->G; }
        bg->pend = -1; asm volatile("s_waitcnt lgkmcnt(0)" ::: "memory"); }
#undef PG8_MMA_BG
#undef PG8_WAIT_V8N
#undef PG8_MMA_M
#undef PG8_SA
#undef PG8_SB
#undef PG8_STAGE
#undef PG8_STAGE_A
#undef PG8_LDA
#undef PG8_LDB
#undef PG8_MMA
#undef PG8_WAIT_V
#undef PG8_WAIT_L
#undef PG8_BAR
#undef PG8_SCHED
}
}
namespace att {
#define ATT_LAS __attribute__((address_space(3)))
typedef unsigned short bf16_t;
typedef short bf16x8 __attribute__((ext_vector_type(8)));
typedef short s16x4 __attribute__((ext_vector_type(4)));
typedef float f32x16 __attribute__((ext_vector_type(16)));
typedef float f32x4 __attribute__((ext_vector_type(4)));
constexpr int KV_PER_B = 2112, NQ_PER_B = 2048, PITCH = 1024;
constexpr int L_K = 0, L_V = 32768, L_NB = 65536, L_WSF = L_NB + 512, L_TAB = L_WSF + 2048, L_Q = L_TAB + 512, ATT_LDS = L_Q + 64;
constexpr float THR = 8.0f;
constexpr int L_BG = 69632, BG_SLOT = 8192, BG_E0 = 4, BG_PER_E = 512;
struct Bg { const float* w; unsigned char* w8; int pos, end; float scale; };
__device__ __forceinline__ void glds16(const void* gsrc, unsigned lds_dst) { unsigned keep;
    asm volatile("s_mov_b32 %0, m0\n\ts_mov_b32 m0, %2\n\ts_nop 0\n\tglobal_load_lds_dwordx4 %1, off\n\ts_mov_b32 m0, %0" : "=&s"(keep) : "v"(gsrc), "s"(lds_dst) : "memory"); }
__device__ __forceinline__ void bg_issue(const Bg& g, ATT_LAS char* lds, int wid, int lane) {
    const int idx = g.pos, e = BG_E0 + idx / BG_PER_E, r = idx % BG_PER_E, nsl = r >> 4, kb = r & 15;
    const float* src = g.w + (size_t)e * 2048 * 4096 + (size_t)(128 * kb + (lane >> 2)) * 4096 + 128 * nsl + 16 * wid + 4 * (lane & 3);
    const unsigned slot = (unsigned)(size_t)(lds + L_BG + wid * BG_SLOT);
#pragma unroll
    for (int i = 0; i < 8; ++i) glds16(src + (size_t)(16 * i) * 4096, (unsigned)__builtin_amdgcn_readfirstlane(slot + i * 1024));
}
__device__ __forceinline__ void bg_consume(const Bg& g, ATT_LAS char* lds, int wid, int lane) {
    asm volatile("s_waitcnt vmcnt(0)" ::: "memory");
    const int idx = g.pos, e = BG_E0 + idx / BG_PER_E, r = idx % BG_PER_E, nsl = r >> 4, kb = r & 15;
    const int nbase = 128 * nsl, drow = (nbase < 2048 ? 256 * (nbase >> 7) : 256 * ((nbase - 2048) >> 7) + 128) + 16 * wid;
    const int n = lane & 15, kq = lane >> 4;
    const ATT_LAS float* sl = (const ATT_LAS float*)(lds + L_BG + wid * BG_SLOT) + (16 * kq) * 16 + n;
    unsigned char* dst = g.w8 + (size_t)e * 4096 * 2048 + (size_t)(drow + n) * 2048 + 128 * kb + 16 * kq;
    const float sc = g.scale;
#pragma unroll
    for (int rd = 0; rd < 2; ++rd) { float v[16];
#pragma unroll
        for (int k = 0; k < 16; ++k) v[k] = sl[(64 * rd + k) * 16] * sc;
        typedef unsigned u32x4_t __attribute__((ext_vector_type(4))); u32x4_t o;
        o.x = __builtin_amdgcn_cvt_pk_fp8_f32(v[2], v[3], __builtin_amdgcn_cvt_pk_fp8_f32(v[0], v[1], 0u, false), true);
        o.y = __builtin_amdgcn_cvt_pk_fp8_f32(v[6], v[7], __builtin_amdgcn_cvt_pk_fp8_f32(v[4], v[5], 0u, false), true);
        o.z = __builtin_amdgcn_cvt_pk_fp8_f32(v[10], v[11], __builtin_amdgcn_cvt_pk_fp8_f32(v[8], v[9], 0u, false), true);
        o.w = __builtin_amdgcn_cvt_pk_fp8_f32(v[14], v[15], __builtin_amdgcn_cvt_pk_fp8_f32(v[12], v[13], 0u, false), true);
        *(u32x4_t*)(dst + 64 * rd) = o; }
}
__host__ __device__ __forceinline__ unsigned off_a(unsigned row, unsigned ch) { return 2048u * (row >> 3) + 512u * (ch >> 2) + 64u * (row & 7) + 16u * ((ch & 3) ^ ((row >> 2) & 3)); }
__device__ __forceinline__ int crow(int r, int hi) { return (r & 3) + 8 * (r >> 2) + 4 * hi; }
__device__ __forceinline__ unsigned cvtpk(float lo, float hi) { unsigned r; asm volatile("v_cvt_pk_bf16_f32 %0, %1, %2" : "=v"(r) : "v"(lo), "v"(hi)); return r; }
typedef short v4i16_t __attribute__((ext_vector_type(4)));
__device__ __forceinline__ s16x4 vtr(const ATT_LAS char* p) { return __builtin_bit_cast(s16x4, __builtin_amdgcn_ds_read_tr16_b64_v4i16((ATT_LAS v4i16_t*)p)); }
struct Job { const bf16_t* Q; const bf16_t* K; const bf16_t* V; bf16_t* O; const float* nb; const float* tab; int fox; };

__device__ __forceinline__ void attn_unit(ATT_LAS char* lds, const Job& J, int b, int qb, Bg& bg) {
    int tid_o = threadIdx.x; asm volatile("" : "+v"(tid_o));
    const int tid = tid_o, lane = tid & 63, r32 = lane & 31, hi = lane >> 5; const int wid = __builtin_amdgcn_readfirstlane(tid >> 6);
    const int i0w = 256 * qb + 32 * wid;
    const int NT = 4 * qb + 5;
    ATT_LAS float* wsf = (ATT_LAS float*)(lds + L_WSF) + wid * 64;
    ATT_LAS float* tabl = (ATT_LAS float*)(lds + L_TAB);
    bf16x8 qr[8];
    { const bf16_t* qp = J.Q + (size_t)(b * NQ_PER_B + i0w + r32) * PITCH + 8 * hi;
#pragma unroll
      for (int ks = 0; ks < 8; ++ks) qr[ks] = *(const bf16x8*)(qp + 16 * ks); }
    f32x16 o[4];
#pragma unroll
    for (int c = 0; c < 4; ++c)
#pragma unroll
        for (int r = 0; r < 16; ++r) o[c][r] = 0.f;
    float mrun = -1e30f, lrun = 0.f;
    const int srow = tid >> 4, sch = tid & 15;
    const bf16_t* kg = J.K + (size_t)(b * KV_PER_B + srow) * PITCH + sch * 8;
    const bf16_t* vg = J.V + (size_t)(b * KV_PER_B + srow) * PITCH + sch * 8;
    const unsigned st0 = off_a(srow, sch), st1 = off_a(srow + 32, sch);
    const float* nbg = J.nb + (size_t)b * KV_PER_B;
    if (!J.fox && tid < 128) tabl[tid] = J.tab[tid];
    const unsigned y = (r32 >> 2) & 3;
    const unsigned kb0 = 2048u * (r32 >> 3) + 64u * (r32 & 7) + 16u * ((unsigned)hi ^ y), kb1 = 2048u * (r32 >> 3) + 64u * (r32 & 7) + 16u * (((unsigned)hi ^ y) ^ 2u);
    const unsigned q4 = (lane & 15) >> 2, p4 = lane & 3, b16 = (lane >> 4) & 1;
    const unsigned vb0 = 64u * (4u * hi + q4) + 16u * (2u * (b16 ^ 0u) + ((p4 >> 1) ^ (unsigned)hi)) + 8u * (p4 & 1);
    const unsigned vb1 = 2048u + 64u * (4u * hi + q4) + 16u * (2u * (b16 ^ 1u) + ((p4 >> 1) ^ (unsigned)hi)) + 8u * (p4 & 1);
    bf16x8 sk0, sk1, sv0, sv1; float snb = 0.f;
    sk0 = *(const bf16x8*)(kg); sk1 = *(const bf16x8*)(kg + 32 * PITCH); sv0 = *(const bf16x8*)(vg); sv1 = *(const bf16x8*)(vg + 32 * PITCH);
    if (J.fox && tid < 64) snb = nbg[tid];
    *(ATT_LAS bf16x8*)(lds + L_K + st0) = sk0; *(ATT_LAS bf16x8*)(lds + L_K + st1) = sk1; *(ATT_LAS bf16x8*)(lds + L_V + st0) = sv0; *(ATT_LAS bf16x8*)(lds + L_V + st1) = sv1;
    if (J.fox && tid < 64) ((ATT_LAS float*)(lds + L_NB))[tid] = snb;
    __syncthreads();
    for (int t = 0; t < NT; ++t) {
        const int buf = t & 1;
        const bool more = (t + 1 < NT);
        const bool bgon = bg.pos < bg.end;
        if (bgon) bg_issue(bg, lds, wid, lane);
        if (more) { const size_t go = (size_t)(t + 1) * 64 * PITCH;
            sk0 = *(const bf16x8*)(kg + go); sk1 = *(const bf16x8*)(kg + go + 32 * PITCH); sv0 = *(const bf16x8*)(vg + go); sv1 = *(const bf16x8*)(vg + go + 32 * PITCH);
            if (J.fox && tid < 64) snb = nbg[(t + 1) * 64 + tid]; }
        const int j0 = 64 * (t - 1);
        const bool skip = (t > 0) && (j0 > i0w + 31);
        if (!skip) {
            const ATT_LAS char* Kb = lds + L_K + buf * 16384; const ATT_LAS char* Vb = lds + L_V + buf * 16384;
            f32x16 p0, p1;
            const float mref = (t == 0) ? 0.f : mrun;
            if (J.fox) {
                const ATT_LAS float* nbl = (const ATT_LAS float*)(lds + L_NB) + buf * 64 + 4 * hi;
#pragma unroll
                for (int g = 0; g < 4; ++g) { const f32x4 a = *(const ATT_LAS f32x4*)(nbl + 8 * g), c = *(const ATT_LAS f32x4*)(nbl + 32 + 8 * g);
#pragma unroll
                    for (int e = 0; e < 4; ++e) { p0[4 * g + e] = a[e] - mref; p1[4 * g + e] = c[e] - mref; } }
            } else {
                const bool near = (t == 0) ? (i0w < 112) : (i0w - j0 < 176);
                if (near) { const int dbase = (t == 0) ? (16 + i0w + r32) : (i0w + r32 - j0);
#pragma unroll
                    for (int r = 0; r < 16; ++r) { int d0 = dbase - crow(r, hi), d1 = d0 - 32; d0 = d0 < 0 ? 0 : (d0 > 127 ? 127 : d0); d1 = d1 < 0 ? 0 : (d1 > 127 ? 127 : d1); p0[r] = tabl[d0] - mref; p1[r] = tabl[d1] - mref; }
                } else { const float cf = tabl[127] - mref;
#pragma unroll
                    for (int r = 0; r < 16; ++r) { p0[r] = cf; p1[r] = cf; } }
            }
#pragma unroll
            for (int ks = 0; ks < 8; ++ks) { const unsigned kb = ((ks & 1) ? kb1 : kb0) + 512u * (ks >> 1);
                const bf16x8 a0 = *(const ATT_LAS bf16x8*)(Kb + kb), a1 = *(const ATT_LAS bf16x8*)(Kb + kb + 8192);
                p0 = __builtin_amdgcn_mfma_f32_32x32x16_bf16(a0, qr[ks], p0, 0, 0, 0); p1 = __builtin_amdgcn_mfma_f32_32x32x16_bf16(a1, qr[ks], p1, 0, 0, 0);
                if ((ks & 3) == 3) __builtin_amdgcn_sched_barrier(0); }
            const float NEG = -__builtin_inff();
            if (t == 0) {
#pragma unroll
                for (int r = 8; r < 16; ++r) p0[r] = NEG;
#pragma unroll
                for (int r = 0; r < 16; ++r) p1[r] = NEG;
            } else if (j0 + 63 > i0w) { const int lim = i0w + r32 - j0;
#pragma unroll
                for (int r = 0; r < 16; ++r) { const int kk = crow(r, hi); if (kk > lim) p0[r] = NEG; if (kk + 32 > lim) p1[r] = NEG; } }
            float rm = __builtin_fmaxf(__builtin_fmaxf(p0[0], p0[1]), p0[2]), rm1 = __builtin_fmaxf(__builtin_fmaxf(p1[0], p1[1]), p1[2]);
#pragma unroll
            for (int r = 3; r < 15; r += 2) { rm = __builtin_fmaxf(__builtin_fmaxf(rm, p0[r]), p0[r + 1]); rm1 = __builtin_fmaxf(__builtin_fmaxf(rm1, p1[r]), p1[r + 1]); }
            rm = __builtin_fmaxf(__builtin_fmaxf(rm, rm1), fmaxf(p0[15], p1[15]));
            { auto rr = __builtin_amdgcn_permlane32_swap(__float_as_uint(rm), __float_as_uint(rm), false, false); rm = fmaxf(__uint_as_float(rr[0]), __uint_as_float(rr[1])); }
            const float mn = rm + mref; const bool need = mn > mrun + THR;
            if (__any(need)) {
                const float alpha = need ? __builtin_amdgcn_exp2f(mrun - mn) : 1.0f, sub = need ? rm : 0.f; mrun = need ? mn : mrun; lrun *= alpha;
                if (hi == 0) wsf[r32] = alpha;
                asm volatile("s_waitcnt lgkmcnt(0)" ::: "memory");
#pragma unroll
                for (int r = 0; r < 16; ++r) { const float a = wsf[crow(r, hi)]; p0[r] -= sub; p1[r] -= sub;
#pragma unroll
                    for (int c = 0; c < 4; ++c) o[c][r] *= a; }
            }
            float ls = 0.f;
#pragma unroll
            for (int r = 0; r < 16; ++r) { p0[r] = __builtin_amdgcn_exp2f(p0[r]); p1[r] = __builtin_amdgcn_exp2f(p1[r]); ls += p0[r] + p1[r]; }
            lrun += ls;
            bf16x8 pa[4];
#pragma unroll
            for (int s = 0; s < 4; ++s) { const f32x16& P = (s < 2) ? p0 : p1; const int bb = (s & 1) * 8;
                const unsigned w0 = cvtpk(P[bb + 0], P[bb + 1]), w1 = cvtpk(P[bb + 2], P[bb + 3]), w2 = cvtpk(P[bb + 4], P[bb + 5]), w3 = cvtpk(P[bb + 6], P[bb + 7]);
                typedef unsigned u32x4_t __attribute__((ext_vector_type(4))); const u32x4_t w = {w0, w1, w2, w3}; pa[s] = __builtin_bit_cast(bf16x8, w); }
#pragma unroll
            for (int c = 0; c < 4; ++c)
#pragma unroll
                for (int s = 0; s < 4; ++s) { const s16x4 lo = vtr(Vb + vb0 + 4096u * s + 512u * c), hh = vtr(Vb + vb1 + 4096u * s + 512u * c);
                    const bf16x8 vv = {lo[0], lo[1], lo[2], lo[3], hh[0], hh[1], hh[2], hh[3]};
                    o[c] = __builtin_amdgcn_mfma_f32_32x32x16_bf16(pa[s], vv, o[c], 0, 0, 0); if (s == 3) __builtin_amdgcn_sched_barrier(0); }
        }
        if (more) { const int nb_ = buf ^ 1;
            *(ATT_LAS bf16x8*)(lds + L_K + nb_ * 16384 + st0) = sk0; *(ATT_LAS bf16x8*)(lds + L_K + nb_ * 16384 + st1) = sk1; *(ATT_LAS bf16x8*)(lds + L_V + nb_ * 16384 + st0) = sv0; *(ATT_LAS bf16x8*)(lds + L_V + nb_ * 16384 + st1) = sv1;
            if (J.fox && tid < 64) ((ATT_LAS float*)(lds + L_NB))[nb_ * 64 + tid] = snb; }
        if (bgon) bg_consume(bg, lds, wid, lane);
        ++bg.pos;
        asm volatile("s_waitcnt lgkmcnt(0)\n\ts_barrier" ::: "memory");
    }
    { auto rr = __builtin_amdgcn_permlane32_swap(__float_as_uint(lrun), __float_as_uint(lrun), false, false); lrun = __uint_as_float(rr[0]) + __uint_as_float(rr[1]); }
    if (hi == 0) wsf[32 + r32] = lrun;
    asm volatile("s_waitcnt lgkmcnt(0)" ::: "memory");
    bf16_t* Ow = J.O + (size_t)(b * NQ_PER_B + i0w) * PITCH;
    unsigned voff = (unsigned)(4 * hi * PITCH + r32); asm volatile("" : "+v"(voff));
#pragma unroll
    for (int r = 0; r < 16; ++r) { const float rl = __builtin_amdgcn_rcpf(wsf[32 + crow(r, hi)]);
#pragma unroll
        for (int c = 0; c < 4; ++c) { const unsigned w = cvtpk(o[c][r] * rl, 0.f); Ow[voff + (unsigned)(((r & 3) + 8 * (r >> 2)) * PITCH + 32 * c)] = (bf16_t)(w & 0xffffu); } }
    __syncthreads();
}
}
#ifndef MK_N_LAUNCHES
#define MK_N_LAUNCHES 1
#endif
constexpr int NWAVES = 8;
constexpr int NPHASE = 12;
constexpr int DM = 2048, NB = 4, SEQ = 2048, NMETA = 16, MTOK = NB * SEQ;
constexpr int DIN = 10248, NPROJ = 10240;
constexpr int KVB = 2112;
constexpr int NEXP = 32, TOPK = 4, DEXP = 2048, ECAP = 8192;
constexpr float RMS_EPS = 1e-5f, LOG2E = 1.4426950408889634f;
constexpr float QSCALE = 0.08838834764831845f * 1.4426950408889634f;
constexpr float LAMBDA_INIT = 0.2f;
constexpr size_t MiB = 1u << 20;
constexpr size_t WS_CTL = 0, CTL_ZERO_BYTES = 1 * MiB;
constexpr size_t WS_SMALL = 1 * MiB;
constexpr size_t WS_LOGF = 2 * MiB;
constexpr size_t WS_NB = 3 * MiB;
constexpr size_t WS_TOPI = 4 * MiB, WS_GATE = WS_TOPI + 256 * 1024, WS_RANK = WS_GATE + 256 * 1024;
constexpr size_t WS_WIN = 8 * MiB, WS_WBF = 48 * MiB, WS_WBD = 52 * MiB, WS_WOUT = 56 * MiB, WS_WGU = 64 * MiB, WS_WD = 576 * MiB;
constexpr size_t WS_XN = 832 * MiB, WS_QF = 866 * MiB, WS_KF = 882 * MiB, WS_VF = 899 * MiB, WS_QD = 916 * MiB, WS_KD = 932 * MiB, WS_VD = 949 * MiB;
constexpr size_t WS_GF = 966 * MiB, WS_GD = 998 * MiB, WS_OFOX = 1030 * MiB, WS_ODIFF = 1046 * MiB, WS_AD0 = 1062 * MiB, WS_AD1 = 1078 * MiB;
constexpr size_t WS_T1 = 1094 * MiB, WS_MERGED = 1126 * MiB, WS_H1 = 1158 * MiB, WS_XN2 = 1222 * MiB, WS_XS = 1254 * MiB, WS_ACT = 1766 * MiB, WS_YS = 2278 * MiB, WS_END = 3302 * MiB;
static_assert(WS_WIN + (size_t)NPROJ * DM * 2 <= WS_WBF && WS_WGU + (size_t)NEXP * 4096 * DM * 2 <= WS_WD && WS_WD + (size_t)NEXP * DM * DM * 2 <= WS_XN, "ws map (weights)");
static_assert(WS_XN + (size_t)(MTOK + 256) * DM * 2 <= WS_QF && WS_KF + (size_t)NB * KVB * 1024 * 2 <= WS_VF && WS_XS + (size_t)NEXP * ECAP * DM <= WS_ACT && WS_ACT + (size_t)NEXP * ECAP * DM <= WS_YS && WS_YS + (size_t)NEXP * ECAP * DM * 2 <= WS_END, "ws map (activations)");
constexpr int CW_BAR = 4096;
constexpr int CW_AQ = 8192;
constexpr int CW_ST = 16384;
constexpr int CW_CNT = 8448;
constexpr int RING_OFF = 0, RING_BYTES = 131072;
constexpr int P0_SCR = 16640;
constexpr int MOE_OFF = 135168;
constexpr int MOE_BYTES = 1024;
constexpr int MISC_OFF = MOE_OFF + MOE_BYTES;
constexpr int BGW_OFF = RING_BYTES;
constexpr int LDS_BYTES = 163840;
static_assert(MISC_OFF + 128 <= LDS_BYTES, "LDS map");

#define GAS __attribute__((address_space(1)))
#define LAS __attribute__((address_space(3)))
typedef unsigned short bf16;
typedef unsigned v4u __attribute__((ext_vector_type(4)));
typedef unsigned v2u __attribute__((ext_vector_type(2)));
typedef float f32x4 __attribute__((ext_vector_type(4)));
typedef float f32x16 __attribute__((ext_vector_type(16)));
typedef short bf16x8 __attribute__((ext_vector_type(8)));
typedef GAS unsigned gu32;
#define RLX_AGENT __ATOMIC_RELAXED, __HIP_MEMORY_SCOPE_AGENT
#define LDS_WAIT() asm volatile("s_waitcnt lgkmcnt(0)" ::: "memory")
#define VM_WAIT() asm volatile("s_waitcnt vmcnt(0)" ::: "memory")
__device__ __forceinline__ unsigned f2bf(float f) { unsigned u = __builtin_bit_cast(unsigned, f); return (u + 0x7fffu + ((u >> 16) & 1u)) >> 16; }
__device__ __forceinline__ unsigned pk2(float lo, float hi) { return f2bf(lo) | (f2bf(hi) << 16); }
__device__ __forceinline__ float bflo(unsigned w) { return __uint_as_float(w << 16); }
__device__ __forceinline__ float bfhi(unsigned w) { return __uint_as_float(w & 0xffff0000u); }

#define XB_TMO      128
#define XB_XCNT(j)  (256  + 64 * (j))
#define XB_XSUB(j)  (1280 + 64 * (j))
#define XB_XGEN(j)  (2304 + 64 * (j))
#define XB_TOP      3328
#define XB_TOPGEN   3392
#define XCD_BAR_WORDS 3456
#define XB_SPIN_CAP (1u << 18)

__device__ __forceinline__ unsigned xb_ld(unsigned* p)              { return __hip_atomic_load(p, __ATOMIC_RELAXED, __HIP_MEMORY_SCOPE_AGENT); }
__device__ __forceinline__ unsigned xb_add(unsigned* p, unsigned v) { return __hip_atomic_fetch_add(p, v, __ATOMIC_RELAXED, __HIP_MEMORY_SCOPE_AGENT); }
__device__ __forceinline__ unsigned xb_xcc_id() { return (unsigned)__builtin_amdgcn_s_getreg((3 << 11) | 20) & 0xFu; }
#define XB_SPIN(cond, bar) do { unsigned _sp = 0; while (cond) { __builtin_amdgcn_s_sleep(1); \
    if ((++_sp & 255u) == 0u) { if (xb_ld(&(bar)[XB_TMO])) break; if (_sp > XB_SPIN_CAP) { atomicAdd(&(bar)[XB_TMO], 1u); break; } } } } while (0)

struct XcdBarrier {
    unsigned* bar; unsigned x;
    volatile unsigned* st;
};

__device__ __forceinline__ XcdBarrier xcd_barrier_post(unsigned* bar, volatile unsigned* st) {
    XcdBarrier b; b.bar = bar; b.x = xb_xcc_id(); b.st = st;
    if (threadIdx.x == 0) (void)xb_add(&bar[XB_XCNT(b.x)], 1u);
    return b;
}
__device__ __forceinline__ void xcd_barrier_complete(unsigned* bar, unsigned x, unsigned& nloc, unsigned& nx) {
    const unsigned G = gridDim.x * gridDim.y * gridDim.z;
    unsigned sum, cnt, mine, sp = 0u;
    for (;;) {
        sum = 0u; cnt = 0u; mine = 0u;
#pragma unroll
        for (unsigned j = 0; j < 16; ++j) { const unsigned c = xb_ld(&bar[XB_XCNT(j)]); sum += c; cnt += (c > 0u) ? 1u : 0u; mine = (j == x) ? c : mine; }
        if (sum == G) break;
        __builtin_amdgcn_s_sleep(1);
        if ((++sp & 255u) == 0u) { if (xb_ld(&bar[XB_TMO])) break; if (sp > XB_SPIN_CAP) { atomicAdd(&bar[XB_TMO], 1u); break; } }
    }
    nloc = mine > 0u ? mine : 1u; nx = cnt > 0u ? cnt : 1u;
}

__device__ __forceinline__ void xcd_barrier(const XcdBarrier& b) {
    asm volatile("s_waitcnt vmcnt(0)" ::: "memory");
    __syncthreads();
    if (threadIdx.x == 0) {
        unsigned* bar = b.bar;
        __builtin_amdgcn_s_waitcnt(0);
        unsigned nloc = b.st[0], nx = b.st[1];
        if (nloc == 0u) { xcd_barrier_complete(bar, b.x, nloc, nx); b.st[0] = nloc; b.st[1] = nx; }
        const unsigned old = xb_add(&bar[XB_XSUB(b.x)], 1u);
        const unsigned gen = old / nloc;
        if (old + 1u == (gen + 1u) * nloc) {
            __builtin_amdgcn_fence(__ATOMIC_RELEASE, "agent");
            asm volatile("s_waitcnt vmcnt(0)" ::: "memory");
            const unsigned og = xb_add(&bar[XB_TOP], 1u);
            const unsigned tg = og / nx;
            if (og + 1u == (tg + 1u) * nx) xb_add(&bar[XB_TOPGEN], 1u);
            else XB_SPIN(xb_ld(&bar[XB_TOPGEN]) == tg, bar);
            __builtin_amdgcn_fence(__ATOMIC_ACQUIRE, "agent");
            xb_add(&bar[XB_XGEN(b.x)], 1u);
            asm volatile("s_waitcnt vmcnt(0)" ::: "memory");
        } else {
            XB_SPIN(xb_ld(&bar[XB_XGEN(b.x)]) == gen, bar);
            __builtin_amdgcn_fence(__ATOMIC_ACQUIRE, "agent");
            asm volatile("s_waitcnt vmcnt(0)" ::: "memory");
        }
    }
    __syncthreads();
}

__device__ __forceinline__ float wave_sum(float v) {
#pragma unroll
    for (int o = 1; o < 64; o <<= 1) v += __shfl_xor(v, o);
    return v;
}
struct TrB { const float* src; bf16* dst; int ldw, K; };
__device__ __forceinline__ TrB trb_make(const float* W, int ldw, int K, bf16* WT, int src_col0, int dst_row0, int kb, int lane) {
    const int nl = lane & 7, kq = lane >> 3; TrB t; t.ldw = ldw; t.K = K;
    t.src = W + (size_t)(64 * kb + 8 * kq) * ldw + src_col0 + 4 * nl; t.dst = WT + (size_t)(dst_row0 + 4 * nl) * K + 64 * kb + 8 * kq; return t;
}
__device__ __forceinline__ void trb_load(f32x4 (&v)[8], const TrB& t) {
#pragma unroll
    for (int r = 0; r < 8; ++r) v[r] = __builtin_nontemporal_load((const GAS f32x4*)(t.src + (size_t)r * t.ldw));
}
__device__ __forceinline__ void trb_store(const f32x4 (&v)[8], const TrB& t) {
#pragma unroll
    for (int j = 0; j < 4; ++j) { v4u o; o.x = pk2(v[0][j], v[1][j]); o.y = pk2(v[2][j], v[3][j]); o.z = pk2(v[4][j], v[5][j]); o.w = pk2(v[6][j], v[7][j]);
        *(GAS v4u*)(t.dst + (size_t)j * t.K) = o; }
}
struct TrItem { const float* src; unsigned char* dst; };
__device__ __forceinline__ void tr8_load(f32x4 (&v)[16], const float* src, int ldw) {
#pragma unroll
    for (int r = 0; r < 16; ++r) v[r] = __builtin_nontemporal_load((const GAS f32x4*)(src + (size_t)r * ldw));
}
__device__ __forceinline__ void tr8_store(const f32x4 (&v)[16], unsigned char* dst, int Kb, float scale) {
#pragma unroll
    for (int j = 0; j < 4; ++j) { v4u o;
        o.x = __builtin_amdgcn_cvt_pk_fp8_f32(v[2][j] * scale, v[3][j] * scale, __builtin_amdgcn_cvt_pk_fp8_f32(v[0][j] * scale, v[1][j] * scale, 0u, false), true);
        o.y = __builtin_amdgcn_cvt_pk_fp8_f32(v[6][j] * scale, v[7][j] * scale, __builtin_amdgcn_cvt_pk_fp8_f32(v[4][j] * scale, v[5][j] * scale, 0u, false), true);
        o.z = __builtin_amdgcn_cvt_pk_fp8_f32(v[10][j] * scale, v[11][j] * scale, __builtin_amdgcn_cvt_pk_fp8_f32(v[8][j] * scale, v[9][j] * scale, 0u, false), true);
        o.w = __builtin_amdgcn_cvt_pk_fp8_f32(v[14][j] * scale, v[15][j] * scale, __builtin_amdgcn_cvt_pk_fp8_f32(v[12][j] * scale, v[13][j] * scale, 0u, false), true);
        *(GAS v4u*)(dst + (size_t)j * Kb) = o; }
}
__device__ __forceinline__ TrItem tr8_item(int r, const float* w_gu, const float* w_dn, unsigned char* WGU8, unsigned char* WD8, int lane, int& ldw) {
    constexpr int I_GU = 16 * 128, I_DN = 16 * 64; TrItem t; const int nl = lane & 7, kq = lane >> 3;
    if (r < att::BG_E0 * I_GU) { const int e = r / I_GU, q = r % I_GU, kb = q / 128, n0 = 32 * (q % 128);
        const int drow = n0 < 2048 ? 256 * (n0 >> 7) + (n0 & 127) : 256 * ((n0 - 2048) >> 7) + 128 + (n0 & 127);
        ldw = 4096; t.src = w_gu + (size_t)e * DM * 4096 + (size_t)(128 * kb + 16 * kq) * 4096 + n0 + 4 * nl; t.dst = WGU8 + (size_t)e * 4096 * DM + (size_t)(drow + 4 * nl) * DM + 128 * kb + 16 * kq; }
    else { r -= att::BG_E0 * I_GU; const int e = r / I_DN, q = r % I_DN, kb = q / 64, n0 = 32 * (q % 64);
        ldw = DM; t.src = w_dn + (size_t)e * DM * DM + (size_t)(128 * kb + 16 * kq) * DM + n0 + 4 * nl; t.dst = WD8 + (size_t)e * DM * DM + (size_t)(n0 + 4 * nl) * DM + 128 * kb + 16 * kq; }
    return t;
}
__device__ __forceinline__ float log_sigmoid(float z) { return fminf(z, 0.f) - log1pf(expf(-fabsf(z))); }

struct Args { const float* in[22]; float* out; unsigned char* ws; int ph_lo, ph_hi; };

__device__ __forceinline__ void moe_tables(LAS int* mt, const gu32* ctl, int tid) {
    if (tid == 0) { int acc = 0;
        for (int e = 0; e < NEXP; ++e) { const int c = (int)__hip_atomic_load(ctl + CW_CNT + 32 * e, RLX_AGENT); const int n = (c + 255) >> 8; mt[e] = acc; mt[32 + e] = n; mt[128 + e] = c; acc += n; }
        mt[64] = acc; }
    __syncthreads();
}
__device__ __forceinline__ int moe_build_list(LAS int* mt, int nct, int G, int c, int tid) {
    LAS int* list = mt + 72;
    if (tid == 0) { const int T = mt[64], U = T * nct; int n = 0;
        const int R = U / G, Lv = U - R * G; const bool split = Lv > 0 && 2 * Lv <= G && (G & 15) == 0;
        for (int i = 0; i < 24; ++i) { long L = (long)i * G + c; int part = -1;
            if (split && i == R) { const int j = (c >> 4) * 8 + (c & 7); if (j >= Lv) break; part = (c >> 3) & 1; L = (long)R * G + j; }
            if (L >= U) break;
            int wg = (int)L; { const int q = U / 8, r = U % 8, xcd = wg % 8, off = wg / 8; wg = (xcd < r ? xcd * (q + 1) : r * (q + 1) + (xcd - r) * q) + off; }
            int e = 0; while (e < NEXP - 1 && wg >= (mt[e] + mt[32 + e]) * nct) ++e;
            const int local = wg - mt[e] * nct, ne = mt[32 + e]; const int tt = local % ne; int hf = (mt[128 + e] - 256 * tt <= 128) ? 1 : 0;
            if (part >= 0) { if (hf) { if (part == 1) break; } else hf = 1; }
            list[2 * n] = 2 * (e * (ECAP / 256) + tt) + (part == 1 ? 1 : 0); list[2 * n + 1] = (e * nct + local / ne) | (hf << 16); ++n; }
        mt[65] = n; }
    __syncthreads();
    return mt[65];
}

__global__ void __launch_bounds__(NWAVES * 64, 2) hyb_fwd(Args args) {
    extern __shared__ __attribute__((aligned(16))) unsigned char lds_raw[];
    LAS unsigned char* lds = (LAS unsigned char*)lds_raw;
    volatile LAS unsigned* MISC = (volatile LAS unsigned*)(lds + MISC_OFF);
    LAS int* mt = (LAS int*)(lds + MOE_OFF);
    const int tid = threadIdx.x, lane = tid & 63, wave = __builtin_amdgcn_readfirstlane(tid >> 6);
    const int G = gridDim.x, bx = blockIdx.x;
    const int vcu = (G % 8 == 0) ? (bx % 8) * (G / 8) + bx / 8 : bx;
    const int gw = vcu * NWAVES + wave, NGW = G * NWAVES;
    unsigned char* ws = args.ws;
    gu32* ctl = (gu32*)(ws + WS_CTL);
    const float* x = args.in[0]; const float* meta = args.in[1]; const float* relb = args.in[2]; const float* g_attn = args.in[3]; const float* w_in = args.in[4];
    const float* ffb = args.in[5]; const float* lq1 = args.in[6]; const float* lk1 = args.in[7]; const float* lq2 = args.in[8]; const float* lk2 = args.in[9];
    const float* subln = args.in[10]; const float* w_bf = args.in[11]; const float* w_bd = args.in[12]; const float* w_out = args.in[13]; const float* g_ffn = args.in[14];
    const float* w_router = args.in[15]; const float* b_router = args.in[16]; const float* w_gu = args.in[17]; const float* b_gu = args.in[18]; const float* w_dn = args.in[19];
    const float* b_dn = args.in[20]; const float* g_fin = args.in[21];
    float* TAB = (float*)(ws + WS_SMALL); float* LAMP = (float*)(ws + WS_SMALL + 2048); float* LOGFM = (float*)(ws + WS_SMALL + 4096);
    float* LOGF = (float*)(ws + WS_LOGF); float* NBIAS = (float*)(ws + WS_NB);
    int* TOPI = (int*)(ws + WS_TOPI); float* GATE = (float*)(ws + WS_GATE); int* RANK = (int*)(ws + WS_RANK);
    int* ROWTOK = (int*)(ws + WS_XS + 32 * MiB);
    bf16 *WIN = (bf16*)(ws + WS_WIN), *WBF = (bf16*)(ws + WS_WBF), *WBD = (bf16*)(ws + WS_WBD), *WOUT = (bf16*)(ws + WS_WOUT), *WGU = (bf16*)(ws + WS_WGU), *WD = (bf16*)(ws + WS_WD);
    unsigned char *WGU8 = ws + WS_WGU, *WD8 = ws + WS_WD, *XN28 = ws + WS_XN2, *XS8 = ws + WS_XS, *ACT8 = ws + WS_ACT;
    bf16 *XN = (bf16*)(ws + WS_XN), *QF = (bf16*)(ws + WS_QF), *KF = (bf16*)(ws + WS_KF), *VF = (bf16*)(ws + WS_VF), *QD = (bf16*)(ws + WS_QD), *KD = (bf16*)(ws + WS_KD), *VD = (bf16*)(ws + WS_VD);
    bf16 *GF = (bf16*)(ws + WS_GF), *GD = (bf16*)(ws + WS_GD), *OFOX = (bf16*)(ws + WS_OFOX), *AD0 = (bf16*)(ws + WS_AD0), *AD1 = (bf16*)(ws + WS_AD1), *ODIFF = (bf16*)(ws + WS_ODIFF);
    bf16 *T1 = (bf16*)(ws + WS_T1), *MERGED = (bf16*)(ws + WS_MERGED), *XN2 = (bf16*)(ws + WS_XN2), *XS = (bf16*)(ws + WS_XS), *ACT = (bf16*)(ws + WS_ACT); unsigned char* YS = ws + WS_YS;
    float* H1 = (float*)(ws + WS_H1);

    for (int u = tid; u < (LDS_BYTES - MOE_OFF) / 4; u += NWAVES * 64) ((LAS unsigned*)(lds + MOE_OFF))[u] = 0u;
    __syncthreads();
    XcdBarrier bar; bar.bar = (unsigned*)(ctl + CW_BAR); bar.x = 0; bar.st = nullptr;
    if (MK_N_LAUNCHES == 1) bar = xcd_barrier_post((unsigned*)(ctl + CW_BAR), (volatile unsigned*)(ctl + CW_ST + 2 * bx));
    const int lo = args.ph_lo, hi = args.ph_hi;
#ifndef PHMASK
#define PHMASK 0xFFF
#endif
#define IN(k) (((PHMASK >> (k)) & 1) && lo <= (k) && (k) < hi)
#ifndef REPMASK
#define REPMASK 0
#endif
#define REPS(k) ((((REPMASK) >> (k)) & 1) ? 2 : 1)
#define SEAM(k) do { if (IN(k) && IN((k) + 1)) xcd_barrier(bar); } while (0)

    if (IN(0)) for (int rep_ = 0; rep_ < REPS(0); ++rep_) { if (rep_) xcd_barrier(bar);
        int tid_o = threadIdx.x; asm volatile("" : "+v"(tid_o)); const int tid = tid_o, lane = tid_o & 63;
        LAS float* scr = (LAS float*)(lds + RING_OFF + wave * P0_SCR);
        LAS float* wff = (LAS float*)(lds + RING_OFF);
        { float tw[32];
#pragma unroll
          for (int q = 0; q < 32; ++q) { const int i = tid + q * NWAVES * 64; tw[q] = w_in[(size_t)(i >> 3) * DIN + 3072 + (i & 7)]; }
#pragma unroll
          for (int q = 0; q < 32; ++q) { const int i = tid + q * NWAVES * 64; wff[(i & 7) * DM + (i >> 3)] = tw[q]; } }
        __syncthreads();
        constexpr int I_IN = 32 * (NPROJ / 32), I_BF = 16 * 64, I_OUT = 32 * 64;
        constexpr int NITEMS = I_IN + 2 * I_BF + I_OUT;
#define TRB_ITEM(it_) ((it_) < I_IN ? trb_make(w_in, DIN, DM, WIN, (32 * ((it_) % (NPROJ / 32))) < 3072 ? 32 * ((it_) % (NPROJ / 32)) : 32 * ((it_) % (NPROJ / 32)) + 8, 32 * ((it_) % (NPROJ / 32)), (it_) / (NPROJ / 32), lane) \
        : (it_) < I_IN + I_BF ? trb_make(w_bf, DM, 1024, WBF, 32 * (((it_) - I_IN) % 64), 32 * (((it_) - I_IN) % 64), ((it_) - I_IN) / 64, lane) \
        : (it_) < I_IN + 2 * I_BF ? trb_make(w_bd, DM, 1024, WBD, 32 * (((it_) - I_IN - I_BF) % 64), 32 * (((it_) - I_IN - I_BF) % 64), ((it_) - I_IN - I_BF) / 64, lane) \
        : trb_make(w_out, DM, DM, WOUT, 32 * (((it_) - I_IN - 2 * I_BF) % 64), 32 * (((it_) - I_IN - 2 * I_BF) % 64), ((it_) - I_IN - 2 * I_BF) / 64, lane))
        { f32x4 va[8], vb[8]; TrB ta, tb; int it = gw;
          if (it < NITEMS) { ta = TRB_ITEM(it); trb_load(va, ta); }
          while (it < NITEMS) {
              const int it1 = it + NGW; if (it1 < NITEMS) { tb = TRB_ITEM(it1); trb_load(vb, tb); }
              trb_store(va, ta);
              if (it1 >= NITEMS) break;
              const int it2 = it1 + NGW; if (it2 < NITEMS) { ta = TRB_ITEM(it2); trb_load(va, ta); }
              trb_store(vb, tb);
              it = it2; } }
#undef TRB_ITEM
        { const int ROWS_END = MTOK + NMETA; int m = gw < MTOK ? gw : ROWS_END; f32x4 v[8], vn[8], gA[8]; const float ffbv = ffb[lane & 7];
#pragma unroll
          for (int j = 0; j < 8; ++j) gA[j] = *((const GAS f32x4*)g_attn + 64 * j + lane);
          if (m < ROWS_END) { const GAS f32x4* xr = (const GAS f32x4*)(x + (size_t)m * DM) + lane;
#pragma unroll
              for (int j = 0; j < 8; ++j) v[j] = xr[64 * j]; }
          while (m < ROWS_END) {
            int mn = ROWS_END;
            if (m < MTOK) { mn = m + NGW; if (mn >= MTOK) mn = (gw >= 64 && gw < 64 + NMETA) ? MTOK + gw - 64 : ROWS_END; }
            if (mn < ROWS_END) { const GAS f32x4* xr = (const GAS f32x4*)((mn < MTOK) ? x + (size_t)mn * DM : meta + (size_t)(mn - MTOK) * DM) + lane;
#pragma unroll
                for (int j = 0; j < 8; ++j) vn[j] = xr[64 * j]; }
            float ss = 0.f;
#pragma unroll
            for (int j = 0; j < 8; ++j) ss += (v[j].x * v[j].x + v[j].y * v[j].y) + (v[j].z * v[j].z + v[j].w * v[j].w);
            const float rstd = rsqrtf(wave_sum(ss) * (1.f / DM) + RMS_EPS);
            float ff[8];
#pragma unroll
            for (int h = 0; h < 8; ++h) ff[h] = 0.f;
            GAS v2u* o8 = (GAS v2u*)(XN + (size_t)m * DM) + lane;
#pragma unroll
            for (int j = 0; j < 8; ++j) { const f32x4 yv = v[j] * rstd * gA[j];
                v2u w; w.x = pk2(yv.x, yv.y); w.y = pk2(yv.z, yv.w); o8[64 * j] = w;
#pragma unroll
                for (int h = 0; h < 8; ++h) { const f32x4 w4 = *(const LAS f32x4*)(wff + h * DM + 256 * j + 4 * lane); ff[h] += (yv.x * w4.x + yv.y * w4.y) + (yv.z * w4.z + yv.w * w4.w); }
                asm volatile("" ::: "memory"); }
            float r4[4], r2[2], r1;
            { const bool b0 = lane & 1;
#pragma unroll
              for (int i = 0; i < 4; ++i) { const float keep = b0 ? ff[2 * i + 1] : ff[2 * i], send = b0 ? ff[2 * i] : ff[2 * i + 1]; r4[i] = keep + __shfl_xor(send, 1); }
              const bool b1 = lane & 2;
#pragma unroll
              for (int i = 0; i < 2; ++i) { const float keep = b1 ? r4[2 * i + 1] : r4[2 * i], send = b1 ? r4[2 * i] : r4[2 * i + 1]; r2[i] = keep + __shfl_xor(send, 2); }
              const bool b2 = lane & 4; const float keep = b2 ? r2[1] : r2[0], send = b2 ? r2[0] : r2[1]; r1 = keep + __shfl_xor(send, 4);
              r1 += __shfl_xor(r1, 8); r1 += __shfl_xor(r1, 16); r1 += __shfl_xor(r1, 32); }
            if (lane < 8) { const float lf = log_sigmoid(r1 + ffbv); if (m < MTOK) LOGF[(size_t)m * 8 + lane] = lf; else LOGFM[(m - MTOK) * 8 + lane] = lf; }
#pragma unroll
            for (int j = 0; j < 8; ++j) v[j] = vn[j];
            m = mn; } }
        if (vcu == G - 1) {
            { const int i = tid, h = i >> 7, d = i & 127; int bk;
                if (d < 16) bk = d; else { const float lp = logf((float)d / 16.0f) / 2.0794415416798357f; bk = 16 + (int)(lp * 16.0f); bk = bk > 31 ? 31 : bk; }
                TAB[i] = relb[bk * 4 + h] * LOG2E; }
          if (wave == 0) {
            float s1 = lq1[lane] * lk1[lane] + lq1[lane + 64] * lk1[lane + 64], s2 = lq2[lane] * lk2[lane] + lq2[lane + 64] * lk2[lane + 64];
            s1 = wave_sum(s1); s2 = wave_sum(s2);
            if (lane == 0) LAMP[0] = expf(s1) - expf(s2) + LAMBDA_INIT; }
        }
        for (int i = gw; i < 4 * NB * 48; i += NGW) { const int bufi = i / (NB * 48), rr = i % (NB * 48), b = rr / 48, kv = 16 + rr % 48;
            bf16* base = bufi == 0 ? KF : bufi == 1 ? VF : bufi == 2 ? KD : VD; GAS v4u* p = (GAS v4u*)(base + (size_t)(b * KVB + kv) * 1024);
            p[lane] = (v4u){0u, 0u, 0u, 0u}; p[lane + 64] = (v4u){0u, 0u, 0u, 0u}; }
    }
    SEAM(0);

    if (IN(1)) for (int rep_ = 0; rep_ < REPS(1); ++rep_) { if (rep_) xcd_barrier(bar);
        int tid_o = threadIdx.x; asm volatile("" : "+v"(tid_o)); const int tid = tid_o, lane = tid_o & 63;
        for (int job = bx; job < 96; job += G) {
            if (job < 64) {
                const int q0 = 64 * job; f32x4 acc[4];
#pragma unroll
                for (int nb = 0; nb < 4; ++nb) acc[nb] = (f32x4){0.f, 0.f, 0.f, 0.f};
                const bf16* ap = XN + (size_t)(MTOK + (lane & 15)) * DM + 256 * wave + 8 * (lane >> 4);
#pragma unroll
                for (int st = 0; st < 8; ++st) { const bf16x8 a = *(const bf16x8*)(ap + 32 * st);
#pragma unroll
                    for (int nb = 0; nb < 4; ++nb) { const int q = q0 + 16 * nb + (lane & 15); const int wrow = q < 2048 ? 1024 + q : 2048 + q;
                        const bf16x8 bq = *(const bf16x8*)(WIN + (size_t)wrow * DM + 256 * wave + 32 * st + 8 * (lane >> 4));
                        acc[nb] = __builtin_amdgcn_mfma_f32_16x16x32_bf16(a, bq, acc[nb], 0, 0, 0); } }
                LAS float* part = (LAS float*)(lds + RING_OFF);
#pragma unroll
                for (int nb = 0; nb < 4; ++nb)
#pragma unroll
                    for (int r = 0; r < 4; ++r) part[(wave * 16 + (lane >> 4) * 4 + r) * 64 + 16 * nb + (lane & 15)] = acc[nb][r];
                __syncthreads();
                for (int idx = tid; idx < 1024; idx += NWAVES * 64) { const int row = idx >> 6, col = idx & 63; float s = 0.f;
#pragma unroll
                    for (int w = 0; w < 8; ++w) s += part[(w * 16 + row) * 64 + col];
                    const int q = q0 + col; bf16* base = q < 1024 ? KF : q < 2048 ? VF : q < 3072 ? KD : VD; const bf16 hv = (bf16)f2bf(s);
#pragma unroll
                    for (int b = 0; b < NB; ++b) base[(size_t)(b * KVB + row) * 1024 + (q & 1023)] = hv; }
                __syncthreads();
            } else if (wave == 0) {
                const int b = (job - 64) >> 3, h = (job - 64) & 7; float* nbp = NBIAS + (size_t)(b * 8 + h) * KVB; float v[33];
#pragma unroll
                for (int ch = 0; ch < 33; ++ch) { const int p = 64 * ch + lane; v[ch] = 0.f;
                    if (p < NMETA) v[ch] = LOGFM[p * 8 + h]; else if (p < NMETA + SEQ) v[ch] = LOGF[(size_t)(b * SEQ + p - NMETA) * 8 + h]; }
                float carry = 0.f;
#pragma unroll
                for (int ch = 0; ch < 33; ++ch) { const int p = 64 * ch + lane; float x = v[ch];
#pragma unroll
                    for (int o = 1; o < 64; o <<= 1) { const float t = __shfl_up(x, o); if (lane >= o) x += t; }
                    x += carry;
                    if (p < NMETA + SEQ) nbp[p < NMETA ? p : p + 48] = -x * LOG2E;
                    carry = __shfl(x, 63); }
                if (lane >= 16) nbp[lane] = 0.f;
            }
        }
        __syncthreads();
        pg8::Gemm g{XN, WIN, MTOK, NPROJ, DM}; pg8::StaticOrder S; S.init(MTOK, NPROJ, G, bx);
        pg8::EpiInProj E{QF, KF, VF, QD, KD, VD, GF, GD, QSCALE};
        pg8::BgW bgw{w_gu, w_dn, WGU8, WD8, bx, 1024 * att::BG_E0 + 16384, G, -1, pg8::W8_SCALE, 1024 * att::BG_E0, pg8::BGW_GU - 1024 * att::BG_E0};
        pg8::gemm_phase<pg8::EpiInProj, pg8::StaticOrder, true, true, false, 0>(lds + RING_OFF, g, S, E, &bgw);
    }
    SEAM(1);

    if (IN(2)) for (int rep_ = 0; rep_ < REPS(2); ++rep_) { if (rep_) xcd_barrier(bar);
        int tid_o = threadIdx.x; asm volatile("" : "+v"(tid_o)); const int tid = tid_o, lane = tid_o & 63;
        LAS int* qslot = (LAS int*)(lds + RING_OFF + att::L_Q);
        att::Bg bg; { const int total = (NEXP - att::BG_E0) * att::BG_PER_E, per = (total + G - 1) / G; bg.w = w_gu; bg.w8 = WGU8; bg.pos = bx * per; bg.end = (bx * per + per < total) ? bx * per + per : total; bg.scale = pg8::W8_SCALE; if (rep_) bg.end = bg.pos; }
        for (;;) {
            if (tid == 0) *qslot = (int)__hip_atomic_fetch_add(ctl + CW_AQ + 64 * rep_, 1u, RLX_AGENT);
            __syncthreads();
            const int u = __builtin_amdgcn_readfirstlane(*qslot);
            __syncthreads();
            if (u >= 768) break;
            const int qb = 7 - u / 96, rem = u % 96, jb = rem >> 2, b = rem & 3;
            att::Job J;
            if (jb < 8) { J.Q = QF + jb * 128; J.K = KF + jb * 128; J.V = VF + jb * 128; J.O = OFOX + jb * 128; J.nb = NBIAS + (size_t)jb * KVB; J.tab = TAB; J.fox = 1; }
            else { const int d = jb - 8, h = d >> 2, mp = (d >> 1) & 1, vh = d & 1;
                J.Q = QD + h * 256 + mp * 128; J.K = KD + h * 256 + mp * 128; J.V = VD + h * 256 + vh * 128; J.O = (mp ? AD1 : AD0) + h * 256 + vh * 128; J.nb = NBIAS; J.tab = TAB + h * 128; J.fox = 0; }
            if (jb < 8) J.nb += (size_t)b * 7 * KVB;
            att::attn_unit((LAS char*)(lds + RING_OFF), J, b, qb, bg);
        }
        while (bg.pos < bg.end) { att::bg_issue(bg, (LAS char*)(lds + RING_OFF), wave, lane); att::bg_consume(bg, (LAS char*)(lds + RING_OFF), wave, lane); ++bg.pos; asm volatile("s_waitcnt lgkmcnt(0)" ::: "memory"); }
    }
    SEAM(2);

    if (IN(3)) for (int rep_ = 0; rep_ < REPS(3); ++rep_) { if (rep_) xcd_barrier(bar);
        int tid_o = threadIdx.x; asm volatile("" : "+v"(tid_o)); const int tid = tid_o, lane = tid_o & 63;
        const float lam = LAMP[0];
        const int sub = lane & 15;
        f32x4 sl[4];
#pragma unroll
        for (int i = 0; i < 4; ++i) sl[i] = *(const f32x4*)(subln + sub * 16 + 4 * i);
        for (int m = gw; m < MTOK; m += NGW) {
            const size_t off = (size_t)m * 1024 + lane * 16;
            const v4u a0 = *(const GAS v4u*)(AD0 + off), a1 = *(const GAS v4u*)(AD0 + off + 8), c0 = *(const GAS v4u*)(AD1 + off), c1 = *(const GAS v4u*)(AD1 + off + 8);
            float a[16];
#pragma unroll
            for (int i = 0; i < 4; ++i) { a[2 * i] = bflo(a0[i]) - lam * bflo(c0[i]); a[2 * i + 1] = bfhi(a0[i]) - lam * bfhi(c0[i]); a[8 + 2 * i] = bflo(a1[i]) - lam * bflo(c1[i]); a[8 + 2 * i + 1] = bfhi(a1[i]) - lam * bfhi(c1[i]); }
            float ss = 0.f;
#pragma unroll
            for (int i = 0; i < 16; ++i) ss += a[i] * a[i];
            ss += __shfl_xor(ss, 1); ss += __shfl_xor(ss, 2); ss += __shfl_xor(ss, 4); ss += __shfl_xor(ss, 8);
            const float rs = rsqrtf(ss * (1.f / 256.f) + RMS_EPS) * (1.0f - LAMBDA_INIT);
            v4u o0, o1;
#pragma unroll
            for (int i = 0; i < 4; ++i) { o0[i] = pk2(a[2 * i] * rs * sl[i >> 1][(2 * i) & 3], a[2 * i + 1] * rs * sl[i >> 1][(2 * i + 1) & 3]);
                                          o1[i] = pk2(a[8 + 2 * i] * rs * sl[2 + (i >> 1)][(2 * i) & 3], a[8 + 2 * i + 1] * rs * sl[2 + (i >> 1)][(2 * i + 1) & 3]); }
            *(GAS v4u*)(ODIFF + off) = o0; *(GAS v4u*)(ODIFF + off + 8) = o1;
        }
    }
    SEAM(3);

    if (IN(4)) for (int rep_ = 0; rep_ < REPS(4); ++rep_) { if (rep_) xcd_barrier(bar);
        int tid_o = threadIdx.x; asm volatile("" : "+v"(tid_o)); const int tid = tid_o, lane = tid_o & 63;
        pg8::Gemm g{OFOX, WBF, 2 * MTOK, 2 * DM, 1024}; pg8::PairOrder S; S.S.init(MTOK, DM, G, bx);
        pg8::EpiGate2 E{GF, GD, T1, MERGED};
        pg8::gemm_phase<pg8::EpiGate2, pg8::PairOrder, true, true>(lds + RING_OFF, g, S, E);
    }
    SEAM(4);
    if (IN(5)) { }
    if (IN(6)) for (int rep_ = 0; rep_ < REPS(6); ++rep_) { if (rep_) xcd_barrier(bar);
        int tid_o = threadIdx.x; asm volatile("" : "+v"(tid_o)); const int tid = tid_o, lane = tid_o & 63;
        pg8::Gemm g{MERGED, WOUT, MTOK, DM, DM}; pg8::StaticOrder S; S.init(MTOK, DM, G, bx);
        pg8::EpiResF32 E{x, H1};
        pg8::gemm_phase<pg8::EpiResF32, pg8::StaticOrder, true, true>(lds + RING_OFF, g, S, E);
    }
    SEAM(6);

    if (IN(7)) for (int rep_ = 0; rep_ < REPS(7); ++rep_) { if (rep_) xcd_barrier(bar);
        int tid_o = threadIdx.x; asm volatile("" : "+v"(tid_o)); const int tid = tid_o, lane = tid_o & 63;
        LAS float* part = (LAS float*)(lds + RING_OFF);
        LAS float* lg = (LAS float*)(lds + RING_OFF + 32768);
        LAS float* rs = (LAS float*)(lds + RING_OFF + 40960);
        LAS int* hist = (LAS int*)(lds + RING_OFF + 41216);
        LAS int* gbase = (LAS int*)(lds + RING_OFF + 41472);
        LAS int* sel = (LAS int*)(lds + RING_OFF + 41728);
        LAS int* lrank = (LAS int*)(lds + RING_OFF + 42240);
        for (int it = bx; it < MTOK / 32; it += G) {
            const int t0 = 32 * it;
            if (tid < 32) hist[tid] = 0;
            LAS unsigned* xst = (LAS unsigned*)(lds + RING_OFF + 49152);
            { f32x4 v[8], vn[8];
              { const GAS f32x4* xr = (const GAS f32x4*)(H1 + (size_t)(t0 + 4 * wave) * DM) + lane;
#pragma unroll
                for (int j = 0; j < 8; ++j) v[j] = xr[64 * j]; }
#pragma unroll 1
              for (int i = 0; i < 4; ++i) {
                if (i < 3) { const GAS f32x4* xr = (const GAS f32x4*)(H1 + (size_t)(t0 + 4 * wave + i + 1) * DM) + lane;
#pragma unroll
                    for (int j = 0; j < 8; ++j) vn[j] = xr[64 * j]; }
                float ss = 0.f;
#pragma unroll
                for (int j = 0; j < 8; ++j) ss += (v[j].x * v[j].x + v[j].y * v[j].y) + (v[j].z * v[j].z + v[j].w * v[j].w);
                const float rstd = rsqrtf(wave_sum(ss) * (1.f / DM) + RMS_EPS);
                LAS unsigned* xw = xst + (4 * wave + i) * 512 + lane;
#pragma unroll
                for (int j = 0; j < 8; ++j) { const f32x4 g = *((const GAS f32x4*)g_ffn + 64 * j + lane); const f32x4 yv = v[j] * (rstd * pg8::X8_SCALE) * g; xw[64 * j] = pg8::pk4_fp8(yv.x, yv.y, yv.z, yv.w); }
                if (lane == 0) rs[4 * wave + i] = rstd;
#pragma unroll
                for (int j = 0; j < 8; ++j) v[j] = vn[j]; } }
            { f32x16 acc;
#pragma unroll
              for (int r = 0; r < 16; ++r) acc[r] = 0.f;
              const int kk = lane >> 5, col = lane & 31; const float* ap = H1 + (size_t)(t0 + col) * DM + 256 * wave + kk; const float* bp = w_router + (size_t)(256 * wave + kk) * NEXP + col; const float* gp = g_ffn + 256 * wave + kk;
#pragma unroll 8
              for (int s = 0; s < 128; ++s) { const float a = ap[2 * s]; const float bw = bp[(size_t)2 * s * NEXP] * gp[2 * s]; acc = __builtin_amdgcn_mfma_f32_32x32x2f32(a, bw, acc, 0, 0, 0); }
#pragma unroll
              for (int r = 0; r < 16; ++r) part[(wave * 32 + ((r & 3) + 8 * (r >> 2) + 4 * kk)) * 32 + col] = acc[r]; }
            __syncthreads();
            for (int idx = tid; idx < 1024; idx += NWAVES * 64) { const int tok = idx >> 5, e = idx & 31; float s = 0.f;
#pragma unroll
                for (int w = 0; w < 8; ++w) s += part[(w * 32 + tok) * 32 + e];
                lg[tok * 33 + e] = s * rs[tok] + b_router[e]; }
            __syncthreads();
            if (tid < 32) { const int tok = tid; float v[4]; int ix[4]; unsigned used = 0u;
#pragma unroll
                for (int k = 0; k < 4; ++k) { float best = -__builtin_inff(); int bi = 0;
                    for (int e = 0; e < NEXP; ++e) { const float z = lg[tok * 33 + e]; if (!((used >> e) & 1u) && z > best) { best = z; bi = e; } }
                    used |= 1u << bi; v[k] = best; ix[k] = bi; }
                const float e1 = expf(v[1] - v[0]), e2 = expf(v[2] - v[0]), e3 = expf(v[3] - v[0]); const float inv = 1.0f / (1.0f + e1 + e2 + e3);
                const float gt[4] = {inv, e1 * inv, e2 * inv, e3 * inv};
#pragma unroll
                for (int k = 0; k < 4; ++k) { TOPI[(size_t)(t0 + tok) * 4 + k] = ix[k]; GATE[(size_t)(t0 + tok) * 4 + k] = gt[k]; sel[tok * 4 + k] = ix[k]; lrank[tok * 4 + k] = __hip_atomic_fetch_add(hist + ix[k], 1, __ATOMIC_RELAXED, __HIP_MEMORY_SCOPE_WORKGROUP); } }
            __syncthreads();
            if (tid < 32) { const int c = hist[tid]; gbase[tid] = c ? (int)__hip_atomic_fetch_add(ctl + CW_CNT + 32 * tid, (unsigned)c, RLX_AGENT) : 0; }
            __syncthreads();
            if (tid < 128) RANK[(size_t)t0 * 4 + tid] = gbase[sel[tid]] + lrank[tid];
            if (tid < 128) ROWTOK[(size_t)sel[tid] * ECAP + gbase[sel[tid]] + lrank[tid]] = t0 + (tid >> 2);
#pragma unroll 1
            for (int i = 0; i < 4; ++i) { const LAS v4u* xs = (const LAS v4u*)(xst + (4 * wave + i) * 512) + lane; const v4u a = xs[0], b = xs[64];
                GAS v4u* o = (GAS v4u*)(XS8 + (size_t)(t0 + 4 * wave + i) * DM) + lane; o[0] = a; o[64] = b; }
            __syncthreads();
        }
    }
    SEAM(7);

    if (IN(8)) { }

    if (IN(9)) for (int rep_ = 0; rep_ < REPS(9); ++rep_) { if (rep_) xcd_barrier(bar);
        int tid_o = threadIdx.x; asm volatile("" : "+v"(tid_o)); const int tid = tid_o, lane = tid_o & 63;
        moe_tables(mt, ctl, tid);
        const int n = moe_build_list(mt, 16, G, bx, tid);
        LAS int* tokl = (LAS int*)(lds + MOE_OFF + 2048);
        for (int idx = tid; idx < 256 * n; idx += NWAVES * 64) { const int ui = idx >> 8, r = idx & 255; const int rr = 128 * mt[72 + 2 * ui] + r, e = (mt[72 + 2 * ui + 1] & 0xffff) >> 4;
            const int tok = (rr - e * ECAP < mt[128 + e]) ? ROWTOK[rr] : 0; tokl[idx] = tok * DM; }
        __syncthreads();
        pg8::Gemm g{(const bf16*)XS8, (const bf16*)WGU8, 0, 0, DM / 2}; pg8::ListOrder S{(const LAS int*)(mt + 72), n, tokl};
        pg8::EpiSwiglu E{b_gu, ACT8};
        pg8::gemm_phase<pg8::EpiSwiglu, pg8::ListOrder, true, true, true, -1, true>(lds + RING_OFF, g, S, E);
    }
    SEAM(9);
    if (IN(10)) for (int rep_ = 0; rep_ < REPS(10); ++rep_) { if (rep_) xcd_barrier(bar);
        int tid_o = threadIdx.x; asm volatile("" : "+v"(tid_o)); const int tid = tid_o, lane = tid_o & 63;
        moe_tables(mt, ctl, tid);
        const int n = moe_build_list(mt, 8, G, bx, tid);
        pg8::Gemm g{(const bf16*)ACT8, (const bf16*)WD8, 0, 0, DM / 2}; pg8::ListOrder S{(const LAS int*)(mt + 72), n};
        pg8::EpiDown E{b_dn, YS};
        pg8::gemm_phase<pg8::EpiDown, pg8::ListOrder, true, true, true>(lds + RING_OFF, g, S, E);
    }
    SEAM(10);

    if (IN(11)) for (int rep_ = 0; rep_ < REPS(11); ++rep_) { if (rep_) xcd_barrier(bar);
        int tid_o = threadIdx.x; asm volatile("" : "+v"(tid_o)); const int tid = tid_o, lane = tid_o & 63;
        { int m = gw; f32x4 v[8], vn[8]; int dst[4], dstn[4]; float gt[4], gtn[4];
#define P11_FETCH(mm_, vv_, dd_, gg_) do { const GAS f32x4* hr_ = (const GAS f32x4*)(H1 + (size_t)(mm_) * DM) + lane; \
            _Pragma("unroll") for (int j = 0; j < 8; ++j) vv_[j] = hr_[64 * j]; \
            _Pragma("unroll") for (int k = 0; k < 4; ++k) { dd_[k] = __builtin_amdgcn_readfirstlane(TOPI[(size_t)(mm_) * 4 + k]) * ECAP + __builtin_amdgcn_readfirstlane(RANK[(size_t)(mm_) * 4 + k]); gg_[k] = GATE[(size_t)(mm_) * 4 + k]; } } while (0)
          if (m < MTOK) P11_FETCH(m, v, dst, gt);
          while (m < MTOK) {
            const int mn = m + NGW;
            unsigned ys[4][8];
#pragma unroll
            for (int k = 0; k < 4; ++k) { const GAS unsigned* yr = (const GAS unsigned*)(YS + (size_t)dst[k] * DM) + lane;
#pragma unroll
                for (int j = 0; j < 8; ++j) ys[k][j] = yr[64 * j]; }
            if (mn < MTOK) P11_FETCH(mn, vn, dstn, gtn);
#pragma unroll
            for (int k = 0; k < 4; ++k)
#pragma unroll
                for (int j = 0; j < 8; ++j) { const unsigned w = ys[k][j]; const auto lo = __builtin_amdgcn_cvt_pk_f32_fp8(w, false), hi2 = __builtin_amdgcn_cvt_pk_f32_fp8(w, true); const float gk = gt[k] * (1.0f / pg8::Y8_SCALE);
                    v[j].x += gk * lo[0]; v[j].y += gk * lo[1]; v[j].z += gk * hi2[0]; v[j].w += gk * hi2[1]; }
            float ss = 0.f;
#pragma unroll
            for (int j = 0; j < 8; ++j) ss += (v[j].x * v[j].x + v[j].y * v[j].y) + (v[j].z * v[j].z + v[j].w * v[j].w);
            const float rstd = rsqrtf(wave_sum(ss) * (1.f / DM) + RMS_EPS);
            GAS f32x4* orow = (GAS f32x4*)(args.out + (size_t)m * DM) + lane;
#pragma unroll
            for (int j = 0; j < 8; ++j) { const f32x4 g = *((const GAS f32x4*)g_fin + 64 * j + lane); orow[64 * j] = v[j] * rstd * g; }
#pragma unroll
            for (int j = 0; j < 8; ++j) v[j] = vn[j];
#pragma unroll
            for (int k = 0; k < 4; ++k) { dst[k] = dstn[k]; gt[k] = gtn[k]; }
            m = mn; }
#undef P11_FETCH
        }
    }
#undef IN
#undef SEAM
}

extern "C" void kernel_launch(void* const* d_in, const int* in_sizes, int n_in, void* d_out, int out_size, void* d_ws, size_t ws_size, hipStream_t stream) {
    static int grid = 0;
    if (grid == 0) {
        if (n_in != 22 || in_sizes[0] != MTOK * DM || out_size != MTOK * DM || ws_size < WS_END) { fprintf(stderr, "kernel_launch: unexpected shapes (n_in %d, in0 %d, out %d, ws %zu); nothing launched\n", n_in, n_in > 0 ? in_sizes[0] : -1, out_size, ws_size); grid = -1; return; }
        int dev = 0, cus = 0, per_cu = 0;
        if (hipGetDevice(&dev) != hipSuccess || hipDeviceGetAttribute(&cus, hipDeviceAttributeMultiprocessorCount, dev) != hipSuccess) { fprintf(stderr, "kernel_launch: device query failed\n"); grid = -1; return; }
        if (hipFuncSetAttribute((const void*)hyb_fwd, hipFuncAttributeMaxDynamicSharedMemorySize, LDS_BYTES) != hipSuccess) { fprintf(stderr, "kernel_launch: hipFuncSetAttribute failed\n"); grid = -1; return; }
        if (hipOccupancyMaxActiveBlocksPerMultiprocessor(&per_cu, (const void*)hyb_fwd, NWAVES * 64, LDS_BYTES) != hipSuccess || per_cu < 1) fprintf(stderr, "kernel_launch: note: occupancy query reports %d workgroups per CU\n", per_cu);
        (void)hipGetLastError();
        grid = cus;
    }
    if (grid < 0) return;
    if (hipMemsetAsync((char*)d_ws + WS_CTL, 0, CTL_ZERO_BYTES, stream) != hipSuccess) { fprintf(stderr, "kernel_launch: memset failed\n"); return; }
    Args a{};
    for (int i = 0; i < 22; ++i) a.in[i] = (const float*)d_in[i];
    a.out = (float*)d_out; a.ws = (unsigned char*)d_ws;
#if MK_N_LAUNCHES == 1
    a.ph_lo = 0; a.ph_hi = NPHASE;
    hipLaunchKernelGGL(hyb_fwd, dim3(grid), dim3(NWAVES * 64), LDS_BYTES, stream, a);
#else
    for (int p = 0; p < NPHASE; ++p) { a.ph_lo = p; a.ph_hi = p + 1; hipLaunchKernelGGL(hyb_fwd, dim3(grid), dim3(NWAVES * 64), LDS_BYTES, stream, a); }
#endif
    const hipError_t le = hipPeekAtLastError();
    if (le != hipSuccess) fprintf(stderr, "kernel_launch: launch failed: %s\n", hipGetErrorName(le));
}
```

```cpp
#include <hip/hip_runtime.h>
#include <cstdio>
#include <cstdint>
namespace pg8 {
#define PG8_LAS __attribute__((address_space(3)))
typedef unsigned short bf16_t;
typedef short bf16x8 __attribute__((ext_vector_type(8)));
typedef float f32x4 __attribute__((ext_vector_type(4)));
typedef unsigned u32x4 __attribute__((ext_vector_type(4)));
typedef int v4i32 __attribute__((ext_vector_type(4)));
typedef int v8i32 __attribute__((ext_vector_type(8)));
constexpr int BM = 256, BK = 64, HALF = 128, HTB = HALF * BK * 2  , STAGE_BYTES = 8 * HTB, NXCD = 8, WGM = 8;

__host__ __device__ __forceinline__ int lds_byte(int r, int c) { const int st = (r >> 4) * 2 + (c >> 5), rr = r & 15, cc = c & 31, ob = rr * 64 + cc * 2; return st * 1024 + (ob ^ (((ob >> 9) & 1) << 5)); }
__host__ __device__ __forceinline__ void stage_rc(int b, int& R, int& C) { const int st = b / 1024, sb = b % 1024, swz = sb ^ (((sb >> 9) & 1) << 5); R = (st >> 1) * 16 + swz / 64; C = (st & 1) * 32 + (swz % 64) / 2; }
__host__ __device__ __forceinline__ int perm32(int rho) { const int n = rho >> 4, i = rho & 15; return 8 * (i >> 2) + 4 * n + (i & 3); }

struct Unit { int pm, pn, half; };
struct Gemm { const bf16_t* A; const bf16_t* Bt; int M, N, K; };

struct StaticOrder {
    int nM, nN, nwg, G, c;
    __host__ __device__ void init(int M, int N, int G_, int c_) { nM = M / BM; nN = N / BM; nwg = nM * nN; G = G_; c = c_; }
    __host__ __device__ bool next(int i, Unit& u) const {
        const long L = (long)i * G + c; if (L >= nwg) return false;
        int wgid = (int)L; { const int q = nwg / NXCD, r = nwg % NXCD, xcd = wgid % NXCD, off = wgid / NXCD; wgid = (xcd < r ? xcd * (q + 1) : r * (q + 1) + (xcd - r) * q) + off; }
        const int nig = WGM * nN, gid = wgid / nig, fm = gid * WGM, gsz = (nM - fm) < WGM ? (nM - fm) : WGM;
        u.pm = fm + ((wgid % nig) % gsz); u.pn = (wgid % nig) / gsz; u.half = 0; return true;
    }
    __device__ __forceinline__ void a_ready(const Unit&) const {}
    __device__ __forceinline__ void done(const Unit&) const {}
};

__device__ __forceinline__ unsigned cvt_pk_bf16(float lo, float hi) { unsigned r; asm volatile("v_cvt_pk_bf16_f32 %0, %1, %2" : "=v"(r) : "v"(lo), "v"(hi)); return r; }
typedef float f32x2 __attribute__((ext_vector_type(2)));
typedef unsigned u32x2 __attribute__((ext_vector_type(2)));
__device__ __forceinline__ float bf_lo(unsigned w) { return __uint_as_float(w << 16); }
__device__ __forceinline__ float bf_hi(unsigned w) { return __uint_as_float(w & 0xffff0000u); }
__device__ __forceinline__ float sigm(float x) { return __builtin_amdgcn_rcpf(1.0f + __builtin_amdgcn_exp2f(-1.4426950408889634f * x)); }
__device__ __forceinline__ u32x4 pack8(const f32x4& a, const f32x4& b) { u32x4 w; w.x = cvt_pk_bf16(a[0], a[1]); w.y = cvt_pk_bf16(a[2], a[3]); w.z = cvt_pk_bf16(b[0], b[1]); w.w = cvt_pk_bf16(b[2], b[3]); return w; }

__device__ __forceinline__ unsigned pk4_fp8(float a, float b, float c, float d) { unsigned w = __builtin_amdgcn_cvt_pk_fp8_f32(a, b, 0u, false); return __builtin_amdgcn_cvt_pk_fp8_f32(c, d, w, true); }
constexpr float W8_SCALE = 64.0f, X8_SCALE = 8.0f, A8_SCALE = 4.0f, Y8_SCALE = 32.0f;

struct EpiInProj {
    static constexpr bool PERM = true, AFTER_DRAIN = false;
    bf16_t *Qf, *Kf, *Vf, *Qd, *Kd, *Vd, *Gf, *Gd; float qscale;
    __device__ __forceinline__ void operator()(const f32x4 (&acc)[2][2][4][2], const Unit& u, int wr, int wc, int fr, int fq) const {
        const int colt = u.pn * BM, seg = colt >> 10;
        bf16_t* base; int ldc, col, rowoff = 0; float sc = 1.f; bool sg = false;
        const int kvoff = 64 * ((u.pm >> 3) + 1);
        if (seg < 6) { ldc = 1024; col = colt & 1023;
            if (seg == 0) { base = Qf; sc = qscale; } else if (seg == 1) { base = Kf; rowoff = kvoff; } else if (seg == 2) { base = Vf; rowoff = kvoff; }
            else if (seg == 3) { base = Qd; sc = qscale; } else if (seg == 4) { base = Kd; rowoff = kvoff; } else { base = Vd; rowoff = kvoff; } }
        else { ldc = 2048; sg = true; if (seg < 8) { base = Gf; col = colt - 6144; } else { base = Gd; col = colt - 8192; } }
        const int row0 = u.pm * BM + rowoff + wr * 64 + fr, col0 = col + wc * 32 + 8 * fq;
#pragma unroll
        for (int ai = 0; ai < 2; ++ai)
#pragma unroll
            for (int m = 0; m < 4; ++m) { bf16_t* rowp = base + (size_t)(row0 + ai * HALF + m * 16) * ldc + col0;
#pragma unroll
                for (int bj = 0; bj < 2; ++bj) { f32x4 v0 = acc[ai][bj][m][0], v1 = acc[ai][bj][m][1];
                    if (sg) {
#pragma unroll
                        for (int j = 0; j < 4; ++j) { v0[j] = sigm(v0[j]); v1[j] = sigm(v1[j]); } }
                    else { v0 = v0 * sc; v1 = v1 * sc; }
                    *(u32x4*)(rowp + bj * HALF) = pack8(v0, v1); } }
    }
};
struct EpiGate2 {
    static constexpr bool PERM = true, AFTER_DRAIN = false;
    const bf16_t* Gf; const bf16_t* Gd; bf16_t* T1; bf16_t* O;
    __device__ __forceinline__ void operator()(const f32x4 (&acc)[2][2][4][2], const Unit& u, int wr, int wc, int fr, int fq) const {
        const bool second = u.pm >= 32; const int pm = second ? u.pm - 32 : u.pm, pn = second ? u.pn - 8 : u.pn;
        const bf16_t* G = second ? Gd : Gf; bf16_t* out = second ? O : T1;
        const int row0 = pm * BM + wr * 64 + fr, col0 = pn * BM + wc * 32 + 8 * fq;
#pragma unroll
        for (int ai = 0; ai < 2; ++ai)
#pragma unroll
            for (int m = 0; m < 4; ++m) { const size_t off = (size_t)(row0 + ai * HALF + m * 16) * 2048 + col0;
#pragma unroll
                for (int bj = 0; bj < 2; ++bj) { f32x4 v0 = acc[ai][bj][m][0], v1 = acc[ai][bj][m][1];
                    const u32x4 g = *(const u32x4*)(G + off + bj * HALF);
                    v0[0] *= bf_lo(g.x); v0[1] *= bf_hi(g.x); v0[2] *= bf_lo(g.y); v0[3] *= bf_hi(g.y); v1[0] *= bf_lo(g.z); v1[1] *= bf_hi(g.z); v1[2] *= bf_lo(g.w); v1[3] *= bf_hi(g.w);
                    if (second) { const u32x4 t = *(const u32x4*)(T1 + off + bj * HALF);
                        v0[0] += bf_lo(t.x); v0[1] += bf_hi(t.x); v0[2] += bf_lo(t.y); v0[3] += bf_hi(t.y); v1[0] += bf_lo(t.z); v1[1] += bf_hi(t.z); v1[2] += bf_lo(t.w); v1[3] += bf_hi(t.w); }
                    *(u32x4*)(out + off + bj * HALF) = pack8(v0, v1); } }
    }
};
struct PairOrder {
    StaticOrder S;
    __device__ __forceinline__ bool next(int i, Unit& u) const { if (!S.next(i >> 1, u)) return false; if (i & 1) { u.pm += 32; u.pn += 8; } return true; }
    __device__ __forceinline__ void a_ready(const Unit&) const {}
    __device__ __forceinline__ void done(const Unit&) const {}
};
struct EpiResF32 {
    static constexpr bool PERM = false, AFTER_DRAIN = false;
    const float* X; float* C;
    __device__ __forceinline__ void operator()(const f32x4 (&acc)[2][2][4][2], const Unit& u, int wr, int wc, int fr, int fq) const {
        const int row0 = u.pm * BM + wr * 64 + fr, col0 = u.pn * BM + wc * 32 + 4 * fq;
#pragma unroll
        for (int ai = 0; ai < 2; ++ai)
#pragma unroll
            for (int m = 0; m < 4; ++m) { const size_t off = (size_t)(row0 + ai * HALF + m * 16) * 2048 + col0;
#pragma unroll
                for (int bj = 0; bj < 2; ++bj)
#pragma unroll
                    for (int n = 0; n < 2; ++n) { const f32x4 xv = *(const f32x4*)(X + off + bj * HALF + n * 16); *(f32x4*)(C + off + bj * HALF + n * 16) = acc[ai][bj][m][n] + xv; } }
    }
};
struct EpiSwiglu {
    static constexpr bool PERM = true, AFTER_DRAIN = false;
    const float* bgu; unsigned char* ACT;
    __device__ __forceinline__ void operator()(const f32x4 (&acc)[2][2][4][2], const Unit& u, int wr, int wc, int fr, int fq) const {
        const int e = u.pn >> 4, j = u.pn & 15;
        const int row0 = u.pm * HALF + wr * 64 + fr, cl = j * HALF + wc * 32 + 8 * fq;
        const float* bg = bgu + (size_t)e * 4096 + cl;
        const f32x4 bg0 = *(const f32x4*)(bg), bg1 = *(const f32x4*)(bg + 4), bl0 = *(const f32x4*)(bg + 2048), bl1 = *(const f32x4*)(bg + 2048 + 4);
        const float isc = 1.0f / (W8_SCALE * X8_SCALE);
#pragma unroll
        for (int ai = 0; ai < 2; ++ai) { if (ai == 1 && u.half) break;
#pragma unroll
            for (int m = 0; m < 4; ++m) {
                f32x4 g0 = acc[ai][0][m][0] * isc + bg0, g1 = acc[ai][0][m][1] * isc + bg1, l0 = acc[ai][1][m][0] * isc + bl0, l1 = acc[ai][1][m][1] * isc + bl1, a0, a1;
#pragma unroll
                for (int i = 0; i < 4; ++i) {
                    float xg = fminf(g0[i], 7.0f), xl = fminf(fmaxf(l0[i], -7.0f), 7.0f); a0[i] = xg * sigm(1.702f * xg) * (xl + 1.0f) * A8_SCALE;
                    xg = fminf(g1[i], 7.0f); xl = fminf(fmaxf(l1[i], -7.0f), 7.0f); a1[i] = xg * sigm(1.702f * xg) * (xl + 1.0f) * A8_SCALE; }
                u32x2 w; w.x = pk4_fp8(a0[0], a0[1], a0[2], a0[3]); w.y = pk4_fp8(a1[0], a1[1], a1[2], a1[3]);
                *(u32x2*)(ACT + (size_t)(row0 + ai * HALF + m * 16) * 2048 + cl) = w; } }
    }
};
struct EpiDown {
    static constexpr bool PERM = true, AFTER_DRAIN = false;
    const float* bd; unsigned char* YS;
    __device__ __forceinline__ void operator()(const f32x4 (&acc)[2][2][4][2], const Unit& u, int wr, int wc, int fr, int fq) const {
        const int j = u.pn & 7;
        const int row0 = u.pm * HALF + wr * 64 + fr, col0 = j * BM + wc * 32 + 8 * fq;
        const float* bp = bd + (size_t)u.pn * BM + wc * 32 + 8 * fq;
        const float isc = 1.0f / (W8_SCALE * A8_SCALE);
        f32x4 bv[2][2];
#pragma unroll
        for (int bj = 0; bj < 2; ++bj)
#pragma unroll
            for (int n = 0; n < 2; ++n) bv[bj][n] = *(const f32x4*)(bp + bj * HALF + 4 * n);
#pragma unroll
        for (int ai = 0; ai < 2; ++ai) { if (ai == 1 && u.half) break;
#pragma unroll
            for (int m = 0; m < 4; ++m) { unsigned char* rowp = YS + (size_t)(row0 + ai * HALF + m * 16) * 2048 + col0;
#pragma unroll
                for (int bj = 0; bj < 2; ++bj) { const f32x4 y0 = (acc[ai][bj][m][0] * isc + bv[bj][0]) * Y8_SCALE, y1 = (acc[ai][bj][m][1] * isc + bv[bj][1]) * Y8_SCALE;
                    u32x2 w; w.x = pk4_fp8(y0[0], y0[1], y0[2], y0[3]); w.y = pk4_fp8(y1[0], y1[1], y1[2], y1[3]); *(u32x2*)(rowp + bj * HALF) = w; } } }
    }
};
struct ListOrder {
    const PG8_LAS int* list; int n; const PG8_LAS int* tokl;
    __device__ __forceinline__ bool next(int i, Unit& u) const { if (i >= n) return false; u.pm = __builtin_amdgcn_readfirstlane(list[2 * i]); const int w = __builtin_amdgcn_readfirstlane(list[2 * i + 1]); u.pn = w & 0xffff; u.half = w >> 16; return true; }
    __device__ __forceinline__ void a_ready(const Unit&) const {}
    __device__ __forceinline__ void done(const Unit&) const {}
};
struct BgW { const float* w_gu; const float* w_dn; unsigned char* wgu8; unsigned char* wd8; int pos, end, G, pend; float scale; int split, skip; };
constexpr int BGW_GU = 32 * 1024, BGW_ALL = BGW_GU + 32 * 512;
__device__ __forceinline__ void bgw_glds16(const void* gsrc, unsigned lds_dst) { unsigned keep;
    asm volatile("s_mov_b32 %0, m0\n\ts_mov_b32 m0, %2\n\ts_nop 0\n\tglobal_load_lds_dwordx4 %1, off\n\ts_mov_b32 m0, %0" : "=&s"(keep) : "v"(gsrc), "s"(lds_dst) : "memory"); }
__device__ __forceinline__ void bgw_glds16s(const float* sbase, unsigned voff, unsigned lds_dst) { unsigned keep;
    asm volatile("s_mov_b32 %0, m0\n\ts_mov_b32 m0, %3\n\ts_nop 0\n\tglobal_load_lds_dwordx4 %1, %2\n\ts_mov_b32 m0, %0" : "=&s"(keep) : "v"(voff), "s"(sbase), "s"(lds_dst) : "memory"); }
__device__ __forceinline__ void bgw_addr(const BgW& b, int j_, int wid, const float*& src, unsigned char*& dst, int& ldw) {
    const int idx = j_ < b.split ? j_ : j_ + b.skip;
    if (idx < BGW_GU) { const int e = idx >> 10, r = idx & 1023, n64 = r & 63, kb = r >> 6, nb = 64 * n64 + 8 * wid;
        const int drow = nb < 2048 ? 256 * (nb >> 7) + (nb & 127) : 256 * ((nb - 2048) >> 7) + 128 + (nb & 127);
        ldw = 4096; src = b.w_gu + (size_t)e * 2048 * 4096 + (size_t)(128 * kb) * 4096 + nb; dst = b.wgu8 + (size_t)e * 4096 * 2048 + (size_t)drow * 2048 + 128 * kb; }
    else { const int j = idx - BGW_GU, e = j >> 9, r = j & 511, n64 = r & 31, kb = r >> 5, nb = 64 * n64 + 8 * wid;
        ldw = 2048; src = b.w_dn + (size_t)e * 2048 * 2048 + (size_t)(128 * kb) * 2048 + nb; dst = b.wd8 + (size_t)e * 2048 * 2048 + (size_t)nb * 2048 + 128 * kb; }
}
__device__ __forceinline__ void bgw_issue2(const BgW& b, int idx, unsigned slot, int wid, int lane, int h) {
    asm volatile("" : "+v"(lane));
    const float* src; unsigned char* dst; int ldw; bgw_addr(b, idx, wid, src, dst, ldw);
    const unsigned rl = (unsigned)(lane >> 1);
#pragma unroll
    for (int p = 0; p < 2; ++p) { const int pc = 2 * h + p; const unsigned kl = rl ^ ((rl >> 4) & 1u) ^ (2u * (unsigned)(pc & 1));
        bgw_glds16s(src + (size_t)(32 * pc) * ldw, (kl * (unsigned)ldw + 4u * (unsigned)(lane & 1)) * 4u, (unsigned)__builtin_amdgcn_readfirstlane(slot + pc * 1024)); }
}
__device__ __forceinline__ void bgw_cload(float (&v)[16], const PG8_LAS float* sl, int lane) {
    const int kq = lane >> 3, x = (kq & 1) ^ (2 * ((kq >> 1) & 1));
    const PG8_LAS float* p = sl + (kq >> 1) * 256 + (16 * (kq & 1)) * 8 + (lane & 7);
    const PG8_LAS float* p0 = p + (0 ^ x) * 8; const PG8_LAS float* p1 = p + (1 ^ x) * 8; const PG8_LAS float* p2 = p + (2 ^ x) * 8; const PG8_LAS float* p3 = p + (3 ^ x) * 8;
#pragma unroll
    for (int q = 0; q < 4; ++q) { v[4 * q + 0] = p0[32 * q]; v[4 * q + 1] = p1[32 * q]; v[4 * q + 2] = p2[32 * q]; v[4 * q + 3] = p3[32 * q]; }
}
__device__ __forceinline__ void bgw_cstore(const BgW& b, int idx, const float (&v)[16], int wid, int lane) {
    const float* src; unsigned char* dst; int ldw; bgw_addr(b, idx, wid, src, dst, ldw);
    const int n = lane & 7, kq = lane >> 3; const float sc = b.scale; u32x4 o;
    o.x = __builtin_amdgcn_cvt_pk_fp8_f32(v[2] * sc, v[3] * sc, __builtin_amdgcn_cvt_pk_fp8_f32(v[0] * sc, v[1] * sc, 0u, false), true);
    o.y = __builtin_amdgcn_cvt_pk_fp8_f32(v[6] * sc, v[7] * sc, __builtin_amdgcn_cvt_pk_fp8_f32(v[4] * sc, v[5] * sc, 0u, false), true);
    o.z = __builtin_amdgcn_cvt_pk_fp8_f32(v[10] * sc, v[11] * sc, __builtin_amdgcn_cvt_pk_fp8_f32(v[8] * sc, v[9] * sc, 0u, false), true);
    o.w = __builtin_amdgcn_cvt_pk_fp8_f32(v[14] * sc, v[15] * sc, __builtin_amdgcn_cvt_pk_fp8_f32(v[12] * sc, v[13] * sc, 0u, false), true);
    *(u32x4*)(dst + (size_t)n * 2048 + 16 * kq) = o;
}
__device__ __forceinline__ void bgw_st16(const BgW& b, int idx, u32x4 o, int wid, int lane) { const float* src; unsigned char* dst; int ldw; bgw_addr(b, idx, wid, src, dst, ldw); const unsigned off = (unsigned)(lane & 7) * 2048u + 16u * (unsigned)(lane >> 3); *(__attribute__((address_space(1))) u32x4*)((__attribute__((address_space(1))) unsigned char*)dst + off) = o; }
__device__ __forceinline__ void bgw_consume(const BgW& b, int idx, const PG8_LAS float* sl, int wid, int lane) {
    asm volatile("" : "+v"(lane));
    const int kq = lane >> 3, x = (kq & 1) ^ (2 * ((kq >> 1) & 1)); const float sc = b.scale;
    const PG8_LAS float* p = sl + (kq >> 1) * 256 + (16 * (kq & 1)) * 8 + (lane & 7);
    const PG8_LAS float* p0 = p + (0 ^ x) * 8; const PG8_LAS float* p1 = p + (1 ^ x) * 8; const PG8_LAS float* p2 = p + (2 ^ x) * 8; const PG8_LAS float* p3 = p + (3 ^ x) * 8;
    u32x4 o;
    { const float a0 = p0[0], a1 = p1[0], a2 = p2[0], a3 = p3[0], a4 = p0[32], a5 = p1[32], a6 = p2[32], a7 = p3[32];
      o.x = __builtin_amdgcn_cvt_pk_fp8_f32(a2 * sc, a3 * sc, __builtin_amdgcn_cvt_pk_fp8_f32(a0 * sc, a1 * sc, 0u, false), true);
      o.y = __builtin_amdgcn_cvt_pk_fp8_f32(a6 * sc, a7 * sc, __builtin_amdgcn_cvt_pk_fp8_f32(a4 * sc, a5 * sc, 0u, false), true); }
    asm volatile("" ::: "memory");
    { const float a0 = p0[64], a1 = p1[64], a2 = p2[64], a3 = p3[64], a4 = p0[96], a5 = p1[96], a6 = p2[96], a7 = p3[96];
      o.z = __builtin_amdgcn_cvt_pk_fp8_f32(a2 * sc, a3 * sc, __builtin_amdgcn_cvt_pk_fp8_f32(a0 * sc, a1 * sc, 0u, false), true);
      o.w = __builtin_amdgcn_cvt_pk_fp8_f32(a6 * sc, a7 * sc, __builtin_amdgcn_cvt_pk_fp8_f32(a4 * sc, a5 * sc, 0u, false), true); }
    bgw_st16(b, idx, o, wid, lane);
}
__device__ __forceinline__ f32x4 bgw_rd4(const PG8_LAS float* sl, int lane, int q) { const PG8_LAS float* p = sl + (16 * (lane >> 3) + 4 * q) * 8 + (lane & 7); f32x4 v; v.x = p[0]; v.y = p[8]; v.z = p[16]; v.w = p[24]; return v; }
__device__ __forceinline__ unsigned bgw_cvt4(f32x4 v, float sc) { return __builtin_amdgcn_cvt_pk_fp8_f32(v.z * sc, v.w * sc, __builtin_amdgcn_cvt_pk_fp8_f32(v.x * sc, v.y * sc, 0u, false), true); }
template <class Epi, class Sched, bool ALIGN_EPI = false, bool SP2 = false, bool F8 = false, int BGPM = -1, bool GATHER = false>
__device__ __forceinline__ void gemm_phase(PG8_LAS unsigned char* lds, const Gemm g, const Sched& S, const Epi& E, BgW* bg = nullptr) {
    constexpr bool BGON = BGPM >= 0;
    int tid_o = threadIdx.x; asm volatile("" : "+v"(tid_o));
    const int tid = tid_o, wid = __builtin_amdgcn_readfirstlane(tid >> 6), lane = tid & 63, wr = wid >> 2, wc = wid & 3, fr = lane & 15, fq = lane >> 4;
    const int K = g.K, nt = K / BK;
    unsigned voffA[2], voffB[2]; int gR[2]; unsigned gC[2];
#pragma unroll
    for (int i = 0; i < 2; ++i) { int R, C; stage_rc(tid * 16 + i * 8192, R, C); const int Rb = Epi::PERM ? ((R & ~31) + perm32(R & 31)) : R;
        voffA[i] = (unsigned)(R * K + C) * 2u; voffB[i] = (unsigned)(Rb * K + C) * 2u; gR[i] = R; gC[i] = (unsigned)C * 2u; }
    unsigned gc00 = 0, gc01 = 0, gc10 = 0, gc11 = 0, gn00 = 0, gn01 = 0, gn10 = 0, gn11 = 0;
    static_assert(!GATHER || SP2, "gather: SP2 schedule only");
    const size_t kstep = (size_t)(BK * 2);
    const size_t hstep = (size_t)HALF * K * 2;
    const size_t tstep = 2 * hstep;
    const size_t astep = F8 ? hstep : tstep;
    const unsigned ldsw = (unsigned)wid * 1024u;
    const int aoff = lds_byte(wr * 64 + fr, fq * 8), boff = lds_byte(wc * 32 + fr, fq * 8);
#define PG8_SA(b, h) (((b) * 2 + (h)) * HTB)
#define PG8_SB(b, h) ((4 + (b) * 2 + (h)) * HTB)
#define PG8_STAGE(bufoff, gbase, voff) do { _Pragma("unroll") for (int _i = 0; _i < 2; ++_i) \
        __builtin_amdgcn_global_load_lds((const unsigned*)((const char*)(gbase) + (voff)[_i]), (PG8_LAS unsigned*)(lds + (bufoff) + ldsw + _i * 8192), 16, 0, 0); } while (0)
#define PG8_STAGE_A(bufoff, gbase, h, NX) do { if constexpr (GATHER) { unsigned go_[2]; \
            if ((h) == 0) { go_[0] = ((NX) && last_) ? gn00 : gc00; go_[1] = ((NX) && last_) ? gn01 : gc01; } else { go_[0] = ((NX) && last_) ? gn10 : gc10; go_[1] = ((NX) && last_) ? gn11 : gc11; } \
            PG8_STAGE(bufoff, gbase, go_); } \
        else PG8_STAGE(bufoff, (const char*)(gbase) + (h) * hstep, voffA); } while (0)
#define PG8_LDA(dst, b, h) do { _Pragma("unroll") for (int m = 0; m < 4; ++m) _Pragma("unroll") for (int k = 0; k < 2; ++k) dst[m][k] = *(const PG8_LAS bf16x8*)(lds + PG8_SA(b, h) + aoff + m * 2048 + k * 1024); } while (0)
#define PG8_LDB(dst, b, h) do { _Pragma("unroll") for (int n = 0; n < 2; ++n) _Pragma("unroll") for (int k = 0; k < 2; ++k) dst[n][k] = *(const PG8_LAS bf16x8*)(lds + PG8_SB(b, h) + boff + n * 2048 + k * 1024); } while (0)
#define PG8_MMA(ai, bj, At, Bt) do { __builtin_amdgcn_s_setprio(1); \
        if constexpr (F8) { _Pragma("unroll") for (int m = 0; m < 4; ++m) _Pragma("unroll") for (int n = 0; n < 2; ++n) { \
            const v8i32 fa_ = __builtin_shufflevector(__builtin_bit_cast(v4i32, At[m][0]), __builtin_bit_cast(v4i32, At[m][1]), 0, 1, 2, 3, 4, 5, 6, 7); \
            const v8i32 fb_ = __builtin_shufflevector(__builtin_bit_cast(v4i32, Bt[n][0]), __builtin_bit_cast(v4i32, Bt[n][1]), 0, 1, 2, 3, 4, 5, 6, 7); \
            asm volatile("v_mfma_f32_16x16x128_f8f6f4 %0, %1, %2, %0" : "+v"(acc[ai][bj][m][n]) : "v"(fb_), "v"(fa_)); } } \
        else { _Pragma("unroll") for (int m = 0; m < 4; ++m) _Pragma("unroll") for (int n = 0; n < 2; ++n) _Pragma("unroll") for (int k = 0; k < 2; ++k) \
            acc[ai][bj][m][n] = __builtin_amdgcn_mfma_f32_16x16x32_bf16(Bt[n][k], At[m][k], acc[ai][bj][m][n], 0, 0, 0); } \
        __builtin_amdgcn_s_setprio(0); } while (0)
#define PG8_MMA_M(ai, bj, At, Bt, m0, m1) do { __builtin_amdgcn_s_setprio(1); \
        if constexpr (F8) { _Pragma("unroll") for (int m = m0; m < m1; ++m) _Pragma("unroll") for (int n = 0; n < 2; ++n) { \
            const v8i32 fa_ = __builtin_shufflevector(__builtin_bit_cast(v4i32, At[m][0]), __builtin_bit_cast(v4i32, At[m][1]), 0, 1, 2, 3, 4, 5, 6, 7); \
            const v8i32 fb_ = __builtin_shufflevector(__builtin_bit_cast(v4i32, Bt[n][0]), __builtin_bit_cast(v4i32, Bt[n][1]), 0, 1, 2, 3, 4, 5, 6, 7); \
            asm volatile("v_mfma_f32_16x16x128_f8f6f4 %0, %1, %2, %0" : "+v"(acc[ai][bj][m][n]) : "v"(fb_), "v"(fa_)); } } \
        else { _Pragma("unroll") for (int m = m0; m < m1; ++m) _Pragma("unroll") for (int n = 0; n < 2; ++n) _Pragma("unroll") for (int k = 0; k < 2; ++k) \
            acc[ai][bj][m][n] = __builtin_amdgcn_mfma_f32_16x16x32_bf16(Bt[n][k], At[m][k], acc[ai][bj][m][n], 0, 0, 0); } \
        __builtin_amdgcn_s_setprio(0); } while (0)
#define PG8_WAIT_V(n) asm volatile("s_waitcnt vmcnt(" #n ")" ::: "memory")
#define PG8_WAIT_L(n) asm volatile("s_waitcnt lgkmcnt(" #n ")" ::: "memory")
#define PG8_BAR __builtin_amdgcn_s_barrier()
#define PG8_SCHED __builtin_amdgcn_sched_barrier(0)
    int nbg = 0;
#define PG8_WAIT_V8N() do { if constexpr (BGON) { if (nbg == 5) PG8_WAIT_V(13); else if (nbg == 4) PG8_WAIT_V(12); else if (nbg == 1) PG8_WAIT_V(9); else PG8_WAIT_V(8); } else PG8_WAIT_V(8); } while (0)
    const unsigned bg_slot = (unsigned)(size_t)(lds + 131072 + wid * 4096); const PG8_LAS float* bg_sl = (const PG8_LAS float*)(lds + 131072 + wid * 4096);
#define PG8_MMA_BG(At, B0, B1) do { const bool iss_ = bg->pos < bg->end; const bool mm_ = !F8 || !cur.half; \
        if (mm_) { PG8_MMA(1, 0, At, B0); PG8_MMA_M(1, 1, At, B1, 0, 2); } \
        if (iss_) { asm volatile("s_waitcnt lgkmcnt(0)" ::: "memory"); bgw_issue2(*bg, bg->pos, bg_slot, wid, lane, 0); } \
        if (mm_) PG8_MMA_M(1, 1, At, B1, 2, 3); \
        if (iss_) { bgw_issue2(*bg, bg->pos, bg_slot, wid, lane, 1); bg->pend = bg->pos; bg->pos += bg->G; nbg += 4; } else bg->pend = -1; \
        if (mm_) PG8_MMA_M(1, 1, At, B1, 3, 4); } while (0)
    Unit cur, nxt; int ui = 0;
    if (!S.next(0, cur)) return;
    f32x4 acc[2][2][4][2];
#pragma unroll
    for (int a = 0; a < 2; ++a)
#pragma unroll
        for (int b = 0; b < 2; ++b)
#pragma unroll
            for (int m = 0; m < 4; ++m)
#pragma unroll
                for (int n = 0; n < 2; ++n) acc[a][b][m][n] = (f32x4){0.f, 0.f, 0.f, 0.f};
    bf16x8 At[4][2], B0[2][2], B1[2][2];
    const char* cA = GATHER ? (const char*)g.A : (const char*)g.A + (size_t)cur.pm * astep; const char* cB = (const char*)g.Bt + (size_t)cur.pn * tstep;
    if constexpr (GATHER) { const PG8_LAS int* tk = S.tokl; gc00 = (unsigned)tk[gR[0]] + gC[0]; gc01 = (unsigned)tk[gR[1]] + gC[1]; gc10 = (unsigned)tk[128 + gR[0]] + gC[0]; gc11 = (unsigned)tk[128 + gR[1]] + gC[1]; }
    bool last_ = false;
    S.a_ready(cur);
    if constexpr (SP2) {
        PG8_STAGE(PG8_SB(0, 0), cB, voffB); PG8_STAGE(PG8_SB(0, 1), cB + hstep, voffB); PG8_STAGE_A(PG8_SA(0, 0), cA, 0, false); PG8_STAGE_A(PG8_SA(0, 1), cA, 1, false);
        if (wr == 1) PG8_BAR;
        PG8_WAIT_V(2); PG8_BAR;
        PG8_STAGE(PG8_SB(1, 0), cB + kstep, voffB); PG8_STAGE_A(PG8_SA(1, 0), cA + kstep, 0, false); PG8_STAGE(PG8_SB(1, 1), cB + hstep + kstep, voffB);
        PG8_WAIT_V(6); PG8_BAR;
    } else {
        PG8_STAGE(PG8_SB(0, 0), cB, voffB); PG8_STAGE(PG8_SA(0, 0), cA, voffA); PG8_STAGE(PG8_SB(0, 1), cB + hstep, voffB); PG8_STAGE(PG8_SA(0, 1), cA + hstep, voffA);
        if (wr == 1) PG8_BAR;
        PG8_WAIT_V(4); PG8_BAR;
        PG8_STAGE(PG8_SB(1, 0), cB + kstep, voffB); PG8_STAGE(PG8_SA(1, 0), cA + kstep, voffA); PG8_STAGE(PG8_SB(1, 1), cB + hstep + kstep, voffB);
        PG8_WAIT_V(6); PG8_BAR;
    }
    for (;;) {
        const bool has_next = S.next(ui + 1, nxt);
        const char* nA = (GATHER || !has_next) ? cA : (const char*)g.A + (size_t)nxt.pm * astep; const char* nB = has_next ? (const char*)g.Bt + (size_t)nxt.pn * tstep : cB;
        if constexpr (GATHER) { if (has_next) { const PG8_LAS int* tk = S.tokl + 256 * (ui + 1); gn00 = (unsigned)tk[gR[0]] + gC[0]; gn01 = (unsigned)tk[gR[1]] + gC[1]; gn10 = (unsigned)tk[128 + gR[0]] + gC[0]; gn11 = (unsigned)tk[128 + gR[1]] + gC[1]; }
            else { gn00 = gc00; gn01 = gc01; gn10 = gc10; gn11 = gc11; } }
        for (int t = 0; t < nt; t += 2) {
            const bool last = (t == nt - 2); last_ = last;
            const char* a1 = cA + (size_t)(t + 1) * kstep;
            const char* a2 = last ? nA : cA + (size_t)(t + 2) * kstep; const char* b2 = last ? nB : cB + (size_t)(t + 2) * kstep;
            const char* a3 = a2 + kstep; const char* b3 = b2 + kstep;
            if (last && has_next) S.a_ready(nxt);
            if constexpr (SP2) {
            PG8_LDB(B0, 0, 0); PG8_LDB(B1, 0, 1); PG8_SCHED; PG8_LDA(At, 0, 0); PG8_STAGE_A(PG8_SA(1, 1), a1, 1, false);
            PG8_WAIT_V8N(); PG8_WAIT_L(0); PG8_BAR; PG8_MMA(0, 0, At, B0); PG8_MMA(0, 1, At, B1); PG8_BAR; PG8_SCHED;
            PG8_LDA(At, 0, 1); PG8_STAGE(PG8_SB(0, 0), b2, voffB); PG8_STAGE(PG8_SB(0, 1), b2 + hstep, voffB); PG8_STAGE_A(PG8_SA(0, 0), a2, 0, true);
            PG8_WAIT_V8N(); nbg = 0;
            PG8_WAIT_L(0); PG8_BAR; if (!F8 || !cur.half) { PG8_MMA(1, 0, At, B0); PG8_MMA(1, 1, At, B1); } PG8_BAR; PG8_SCHED;
            PG8_LDB(B0, 1, 0); PG8_LDB(B1, 1, 1); PG8_SCHED; PG8_LDA(At, 1, 0); PG8_STAGE_A(PG8_SA(0, 1), a2, 1, true);
            PG8_WAIT_V(8); PG8_WAIT_L(0); PG8_BAR; PG8_MMA(0, 0, At, B0); PG8_MMA(0, 1, At, B1); PG8_BAR; PG8_SCHED;
            PG8_LDA(At, 1, 1); PG8_STAGE(PG8_SB(1, 0), b3, voffB); PG8_STAGE(PG8_SB(1, 1), b3 + hstep, voffB); PG8_STAGE_A(PG8_SA(1, 0), a3, 0, true);
            PG8_WAIT_V(8); PG8_WAIT_L(0);
            if constexpr (BGON) { if ((t & BGPM) == 0 && bg->pend >= 0) { bgw_consume(*bg, bg->pend, bg_sl, wid, lane); nbg = 1; } }
            PG8_BAR;
            if constexpr (BGON) { if ((t & BGPM) == 0) PG8_MMA_BG(At, B0, B1); else if (!F8 || !cur.half) { PG8_MMA(1, 0, At, B0); PG8_MMA(1, 1, At, B1); } }
            else { if (!F8 || !cur.half) { PG8_MMA(1, 0, At, B0); PG8_MMA(1, 1, At, B1); } }
            PG8_BAR; PG8_SCHED;
            } else {
            PG8_LDB(B0, 0, 0); PG8_SCHED; PG8_LDA(At, 0, 0); PG8_STAGE(PG8_SA(1, 1), a1 + hstep, voffA);
            PG8_WAIT_L(8); PG8_BAR; PG8_WAIT_L(0); PG8_MMA(0, 0, At, B0); PG8_BAR; PG8_SCHED;
            PG8_LDB(B1, 0, 1); PG8_STAGE(PG8_SB(0, 0), b2, voffB);
            PG8_BAR; PG8_WAIT_L(0); PG8_MMA(0, 1, At, B1); PG8_BAR;
            PG8_LDA(At, 0, 1); PG8_STAGE(PG8_SA(0, 0), a2, voffA);
            PG8_BAR; PG8_WAIT_L(0); PG8_MMA(1, 0, At, B0); PG8_BAR; PG8_SCHED;
            PG8_STAGE(PG8_SB(0, 1), b2 + hstep, voffB);
            PG8_WAIT_V(6); PG8_BAR; PG8_MMA(1, 1, At, B1); PG8_BAR;
            PG8_LDB(B0, 1, 0); PG8_SCHED; PG8_LDA(At, 1, 0); PG8_STAGE(PG8_SA(0, 1), a2 + hstep, voffA);
            PG8_WAIT_L(8); PG8_BAR; PG8_WAIT_L(0); PG8_MMA(0, 0, At, B0); PG8_BAR; PG8_SCHED;
            PG8_LDB(B1, 1, 1); PG8_STAGE(PG8_SB(1, 0), b3, voffB);
            PG8_BAR; PG8_WAIT_L(0); PG8_MMA(0, 1, At, B1); PG8_BAR;
            PG8_LDA(At, 1, 1); PG8_STAGE(PG8_SA(1, 0), a3, voffA);
            PG8_BAR; PG8_WAIT_L(0); PG8_MMA(1, 0, At, B0); PG8_BAR; PG8_SCHED;
            PG8_STAGE(PG8_SB(1, 1), b3 + hstep, voffB);
            PG8_WAIT_V(6); PG8_BAR; PG8_MMA(1, 1, At, B1); PG8_BAR;
            }
        }
        if constexpr (ALIGN_EPI) { if (wr == 0) PG8_BAR; }
        if constexpr (F8) asm volatile("s_nop 15\n\ts_nop 7" ::: "memory");
        if constexpr (!Epi::AFTER_DRAIN) { E(acc, cur, wr, wc, fr, fq); S.done(cur); }
        if (!has_next) break;
#pragma unroll
        for (int a = 0; a < 2; ++a)
#pragma unroll
            for (int b = 0; b < 2; ++b)
#pragma unroll
                for (int m = 0; m < 4; ++m)
#pragma unroll
                    for (int n = 0; n < 2; ++n) acc[a][b][m][n] = (f32x4){0.f, 0.f, 0.f, 0.f};
        cur = nxt; cA = nA; cB = nB; ++ui;
        if constexpr (GATHER) { gc00 = gn00; gc01 = gn01; gc10 = gn10; gc11 = gn11; }
        if constexpr (ALIGN_EPI) { if (wr == 1) PG8_BAR; }
    }
    PG8_WAIT_V(0);
    if constexpr (!ALIGN_EPI) { if (wr == 0) PG8_BAR; }
    PG8_BAR;
    if constexpr (Epi::AFTER_DRAIN) { E.fused(acc, cur, wr, wc, fr, fq, lds, wid, lane); S.done(cur); }
    if constexpr (BGON) {
        if (bg->pend >= 0) bgw_consume(*bg, bg->pend, bg_sl, wid, lane);
        while (bg->pos < bg->end) { asm volatile("s_waitcnt lgkmcnt(0)" ::: "memory"); bgw_issue2(*bg, bg->pos, bg_slot, wid, lane, 0); bgw_issue2(*bg, bg->pos, bg_slot, wid, lane, 1); asm volatile("s_waitcnt vmcnt(0)" ::: "memory"); bgw_consume(*bg, bg->pos, bg_sl, wid, lane); bg->pos += bg->G; }
        bg->pend = -1; asm volatile("s_waitcnt lgkmcnt(0)" ::: "memory"); }
#undef PG8_MMA_BG
#undef PG8_WAIT_V8N
#undef PG8_MMA_M
#undef PG8_SA
#undef PG8_SB
#undef PG8_STAGE
#undef PG8_STAGE_A
#undef PG8_LDA
#undef PG8_LDB
#undef PG8_MMA
#undef PG8_WAIT_V
#undef PG8_WAIT_L
#undef PG8_BAR
#undef PG8_SCHED
}
}
namespace att {
#define ATT_LAS __attribute__((address_space(3)))
typedef unsigned short bf16_t;
typedef short bf16x8 __attribute__((ext_vector_type(8)));
typedef short s16x4 __attribute__((ext_vector_type(4)));
typedef float f32x16 __attribute__((ext_vector_type(16)));
typedef float f32x4 __attribute__((ext_vector_type(4)));
constexpr int KV_PER_B = 2112, NQ_PER_B = 2048, PITCH = 1024;
constexpr int L_K = 0, L_V = 32768, L_NB = 65536, L_WSF = L_NB + 512, L_TAB = L_WSF + 2048, L_Q = L_TAB + 512, ATT_LDS = L_Q + 64;
constexpr float THR = 8.0f;
constexpr int L_BG = 69632, BG_SLOT = 8192, BG_E0 = 4, BG_PER_E = 512;
struct Bg { const float* w; unsigned char* w8; int pos, end; float scale; int stride; };
__device__ __forceinline__ void glds16(const void* gsrc, unsigned lds_dst) { unsigned keep;
    asm volatile("s_mov_b32 %0, m0\n\ts_mov_b32 m0, %2\n\ts_nop 0\n\tglobal_load_lds_dwordx4 %1, off\n\ts_mov_b32 m0, %0" : "=&s"(keep) : "v"(gsrc), "s"(lds_dst) : "memory"); }
__device__ __forceinline__ void bg_issue(const Bg& g, ATT_LAS char* lds, int wid, int lane) {
    const int idx = g.pos, e = BG_E0 + idx / BG_PER_E, r = idx % BG_PER_E, nsl = r & 31, kb = r >> 5;
    const float* src = g.w + (size_t)e * 2048 * 4096 + (size_t)(128 * kb + (lane >> 2)) * 4096 + 128 * nsl + 16 * wid + 4 * (lane & 3);
    const unsigned slot = (unsigned)(size_t)(lds + L_BG + wid * BG_SLOT);
#pragma unroll
    for (int i = 0; i < 8; ++i) glds16(src + (size_t)(16 * i) * 4096, (unsigned)__builtin_amdgcn_readfirstlane(slot + i * 1024));
}
__device__ __forceinline__ void bg_consume(const Bg& g, ATT_LAS char* lds, int wid, int lane) {
    asm volatile("s_waitcnt vmcnt(0)" ::: "memory");
    const int idx = g.pos, e = BG_E0 + idx / BG_PER_E, r = idx % BG_PER_E, nsl = r & 31, kb = r >> 5;
    const int nbase = 128 * nsl, drow = (nbase < 2048 ? 256 * (nbase >> 7) : 256 * ((nbase - 2048) >> 7) + 128) + 16 * wid;
    const int n = lane & 15, kq = lane >> 4;
    const ATT_LAS float* sl = (const ATT_LAS float*)(lds + L_BG + wid * BG_SLOT) + (16 * kq) * 16 + n;
    unsigned char* dst = g.w8 + (size_t)e * 4096 * 2048 + (size_t)(drow + n) * 2048 + 128 * kb + 16 * kq;
    const float sc = g.scale;
#pragma unroll
    for (int rd = 0; rd < 2; ++rd) { float v[16];
#pragma unroll
        for (int k = 0; k < 16; ++k) v[k] = sl[(64 * rd + k) * 16] * sc;
        typedef unsigned u32x4_t __attribute__((ext_vector_type(4))); u32x4_t o;
        o.x = __builtin_amdgcn_cvt_pk_fp8_f32(v[2], v[3], __builtin_amdgcn_cvt_pk_fp8_f32(v[0], v[1], 0u, false), true);
        o.y = __builtin_amdgcn_cvt_pk_fp8_f32(v[6], v[7], __builtin_amdgcn_cvt_pk_fp8_f32(v[4], v[5], 0u, false), true);
        o.z = __builtin_amdgcn_cvt_pk_fp8_f32(v[10], v[11], __builtin_amdgcn_cvt_pk_fp8_f32(v[8], v[9], 0u, false), true);
        o.w = __builtin_amdgcn_cvt_pk_fp8_f32(v[14], v[15], __builtin_amdgcn_cvt_pk_fp8_f32(v[12], v[13], 0u, false), true);
        *(u32x4_t*)(dst + 64 * rd) = o; }
}
__host__ __device__ __forceinline__ unsigned off_a(unsigned row, unsigned ch) { return 2048u * (row >> 3) + 512u * (ch >> 2) + 64u * (row & 7) + 16u * ((ch & 3) ^ ((row >> 2) & 3)); }
__device__ __forceinline__ int crow(int r, int hi) { return (r & 3) + 8 * (r >> 2) + 4 * hi; }
__device__ __forceinline__ unsigned cvtpk(float lo, float hi) { unsigned r; asm volatile("v_cvt_pk_bf16_f32 %0, %1, %2" : "=v"(r) : "v"(lo), "v"(hi)); return r; }
typedef short v4i16_t __attribute__((ext_vector_type(4)));
__device__ __forceinline__ s16x4 vtr(const ATT_LAS char* p) { return __builtin_bit_cast(s16x4, __builtin_amdgcn_ds_read_tr16_b64_v4i16((ATT_LAS v4i16_t*)p)); }
struct Job { const bf16_t* Q; const bf16_t* K; const bf16_t* V; bf16_t* O; const float* nb; const float* tab; int fox; };

__device__ __forceinline__ void attn_unit(ATT_LAS char* lds, const Job& J, int b, int qb, Bg& bg) {
    int tid_o = threadIdx.x; asm volatile("" : "+v"(tid_o));
    const int tid = tid_o, lane = tid & 63, r32 = lane & 31, hi = lane >> 5; const int wid = __builtin_amdgcn_readfirstlane(tid >> 6);
    const int i0w = 256 * qb + 32 * wid;
    const int NT = 4 * qb + 5;
    ATT_LAS float* wsf = (ATT_LAS float*)(lds + L_WSF) + wid * 64;
    ATT_LAS float* tabl = (ATT_LAS float*)(lds + L_TAB);
    bf16x8 qr[8];
    { const bf16_t* qp = J.Q + (size_t)(b * NQ_PER_B + i0w + r32) * PITCH + 8 * hi;
#pragma unroll
      for (int ks = 0; ks < 8; ++ks) qr[ks] = *(const bf16x8*)(qp + 16 * ks); }
    f32x16 o[4];
#pragma unroll
    for (int c = 0; c < 4; ++c)
#pragma unroll
        for (int r = 0; r < 16; ++r) o[c][r] = 0.f;
    float mrun = -1e30f, lrun = 0.f;
    const int srow = tid >> 4, sch = tid & 15;
    const bf16_t* kg = J.K + (size_t)(b * KV_PER_B + srow) * PITCH + sch * 8;
    const bf16_t* vg = J.V + (size_t)(b * KV_PER_B + srow) * PITCH + sch * 8;
    const unsigned st0 = off_a(srow, sch), st1 = off_a(srow + 32, sch);
    const float* nbg = J.nb + (size_t)b * KV_PER_B;
    if (!J.fox && tid < 128) tabl[tid] = J.tab[tid];
    const unsigned y = (r32 >> 2) & 3;
    const unsigned kb0 = 2048u * (r32 >> 3) + 64u * (r32 & 7) + 16u * ((unsigned)hi ^ y), kb1 = 2048u * (r32 >> 3) + 64u * (r32 & 7) + 16u * (((unsigned)hi ^ y) ^ 2u);
    const unsigned q4 = (lane & 15) >> 2, p4 = lane & 3, b16 = (lane >> 4) & 1;
    const unsigned vb0 = 64u * (4u * hi + q4) + 16u * (2u * (b16 ^ 0u) + ((p4 >> 1) ^ (unsigned)hi)) + 8u * (p4 & 1);
    const unsigned vb1 = 2048u + 64u * (4u * hi + q4) + 16u * (2u * (b16 ^ 1u) + ((p4 >> 1) ^ (unsigned)hi)) + 8u * (p4 & 1);
    bf16x8 sk0, sk1, sv0, sv1; float snb = 0.f;
    sk0 = *(const bf16x8*)(kg); sk1 = *(const bf16x8*)(kg + 32 * PITCH); sv0 = *(const bf16x8*)(vg); sv1 = *(const bf16x8*)(vg + 32 * PITCH);
    if (J.fox && tid < 64) snb = nbg[tid];
    *(ATT_LAS bf16x8*)(lds + L_K + st0) = sk0; *(ATT_LAS bf16x8*)(lds + L_K + st1) = sk1; *(ATT_LAS bf16x8*)(lds + L_V + st0) = sv0; *(ATT_LAS bf16x8*)(lds + L_V + st1) = sv1;
    if (J.fox && tid < 64) ((ATT_LAS float*)(lds + L_NB))[tid] = snb;
    __syncthreads();
    for (int t = 0; t < NT; ++t) {
        const int buf = t & 1;
        const bool more = (t + 1 < NT);
        const bool bgon = bg.pos < bg.end;
        if (bgon) bg_issue(bg, lds, wid, lane);
        if (more) { const size_t go = (size_t)(t + 1) * 64 * PITCH;
            sk0 = *(const bf16x8*)(kg + go); sk1 = *(const bf16x8*)(kg + go + 32 * PITCH); sv0 = *(const bf16x8*)(vg + go); sv1 = *(const bf16x8*)(vg + go + 32 * PITCH);
            if (J.fox && tid < 64) snb = nbg[(t + 1) * 64 + tid]; }
        const int j0 = 64 * (t - 1);
        const bool skip = (t > 0) && (j0 > i0w + 31);
        if (!skip) {
            const ATT_LAS char* Kb = lds + L_K + buf * 16384; const ATT_LAS char* Vb = lds + L_V + buf * 16384;
            f32x16 p0, p1;
            const float mref = (t == 0) ? 0.f : mrun;
            if (J.fox) {
                const ATT_LAS float* nbl = (const ATT_LAS float*)(lds + L_NB) + buf * 64 + 4 * hi;
#pragma unroll
                for (int g = 0; g < 4; ++g) { const f32x4 a = *(const ATT_LAS f32x4*)(nbl + 8 * g), c = *(const ATT_LAS f32x4*)(nbl + 32 + 8 * g);
#pragma unroll
                    for (int e = 0; e < 4; ++e) { p0[4 * g + e] = a[e] - mref; p1[4 * g + e] = c[e] - mref; } }
            } else {
                const bool near = (t == 0) ? (i0w < 112) : (i0w - j0 < 176);
                if (near) { const int dbase = (t == 0) ? (16 + i0w + r32) : (i0w + r32 - j0);
#pragma unroll
                    for (int r = 0; r < 16; ++r) { int d0 = dbase - crow(r, hi), d1 = d0 - 32; d0 = d0 < 0 ? 0 : (d0 > 127 ? 127 : d0); d1 = d1 < 0 ? 0 : (d1 > 127 ? 127 : d1); p0[r] = tabl[d0] - mref; p1[r] = tabl[d1] - mref; }
                } else { const float cf = tabl[127] - mref;
#pragma unroll
                    for (int r = 0; r < 16; ++r) { p0[r] = cf; p1[r] = cf; } }
            }
#pragma unroll
            for (int ks = 0; ks < 8; ++ks) { const unsigned kb = ((ks & 1) ? kb1 : kb0) + 512u * (ks >> 1);
                const bf16x8 a0 = *(const ATT_LAS bf16x8*)(Kb + kb), a1 = *(const ATT_LAS bf16x8*)(Kb + kb + 8192);
                p0 = __builtin_amdgcn_mfma_f32_32x32x16_bf16(a0, qr[ks], p0, 0, 0, 0); p1 = __builtin_amdgcn_mfma_f32_32x32x16_bf16(a1, qr[ks], p1, 0, 0, 0);
                if ((ks & 3) == 3) __builtin_amdgcn_sched_barrier(0); }
            const float NEG = -__builtin_inff();
            if (t == 0) {
#pragma unroll
                for (int r = 8; r < 16; ++r) p0[r] = NEG;
#pragma unroll
                for (int r = 0; r < 16; ++r) p1[r] = NEG;
            } else if (j0 + 63 > i0w) { const int lim = i0w + r32 - j0;
#pragma unroll
                for (int r = 0; r < 16; ++r) { const int kk = crow(r, hi); if (kk > lim) p0[r] = NEG; if (kk + 32 > lim) p1[r] = NEG; } }
            float rm = __builtin_fmaxf(__builtin_fmaxf(p0[0], p0[1]), p0[2]), rm1 = __builtin_fmaxf(__builtin_fmaxf(p1[0], p1[1]), p1[2]);
#pragma unroll
            for (int r = 3; r < 15; r += 2) { rm = __builtin_fmaxf(__builtin_fmaxf(rm, p0[r]), p0[r + 1]); rm1 = __builtin_fmaxf(__builtin_fmaxf(rm1, p1[r]), p1[r + 1]); }
            rm = __builtin_fmaxf(__builtin_fmaxf(rm, rm1), fmaxf(p0[15], p1[15]));
            { auto rr = __builtin_amdgcn_permlane32_swap(__float_as_uint(rm), __float_as_uint(rm), false, false); rm = fmaxf(__uint_as_float(rr[0]), __uint_as_float(rr[1])); }
            const float mn = rm + mref; const bool need = mn > mrun + THR;
            if (__any(need)) {
                const float alpha = need ? __builtin_amdgcn_exp2f(mrun - mn) : 1.0f, sub = need ? rm : 0.f; mrun = need ? mn : mrun; lrun *= alpha;
                if (hi == 0) wsf[r32] = alpha;
                asm volatile("s_waitcnt lgkmcnt(0)" ::: "memory");
#pragma unroll
                for (int r = 0; r < 16; ++r) { const float a = wsf[crow(r, hi)]; p0[r] -= sub; p1[r] -= sub;
#pragma unroll
                    for (int c = 0; c < 4; ++c) o[c][r] *= a; }
            }
            float ls = 0.f;
#pragma unroll
            for (int r = 0; r < 16; ++r) { p0[r] = __builtin_amdgcn_exp2f(p0[r]); p1[r] = __builtin_amdgcn_exp2f(p1[r]); ls += p0[r] + p1[r]; }
            lrun += ls;
            bf16x8 pa[4];
#pragma unroll
            for (int s = 0; s < 4; ++s) { const f32x16& P = (s < 2) ? p0 : p1; const int bb = (s & 1) * 8;
                const unsigned w0 = cvtpk(P[bb + 0], P[bb + 1]), w1 = cvtpk(P[bb + 2], P[bb + 3]), w2 = cvtpk(P[bb + 4], P[bb + 5]), w3 = cvtpk(P[bb + 6], P[bb + 7]);
                typedef unsigned u32x4_t __attribute__((ext_vector_type(4))); const u32x4_t w = {w0, w1, w2, w3}; pa[s] = __builtin_bit_cast(bf16x8, w); }
#pragma unroll
            for (int c = 0; c < 4; ++c)
#pragma unroll
                for (int s = 0; s < 4; ++s) { const s16x4 lo = vtr(Vb + vb0 + 4096u * s + 512u * c), hh = vtr(Vb + vb1 + 4096u * s + 512u * c);
                    const bf16x8 vv = {lo[0], lo[1], lo[2], lo[3], hh[0], hh[1], hh[2], hh[3]};
                    o[c] = __builtin_amdgcn_mfma_f32_32x32x16_bf16(pa[s], vv, o[c], 0, 0, 0); if (s == 3) __builtin_amdgcn_sched_barrier(0); }
        }
        if (more) { const int nb_ = buf ^ 1;
            *(ATT_LAS bf16x8*)(lds + L_K + nb_ * 16384 + st0) = sk0; *(ATT_LAS bf16x8*)(lds + L_K + nb_ * 16384 + st1) = sk1; *(ATT_LAS bf16x8*)(lds + L_V + nb_ * 16384 + st0) = sv0; *(ATT_LAS bf16x8*)(lds + L_V + nb_ * 16384 + st1) = sv1;
            if (J.fox && tid < 64) ((ATT_LAS float*)(lds + L_NB))[nb_ * 64 + tid] = snb; }
        if (bgon) bg_consume(bg, lds, wid, lane);
        bg.pos += bg.stride;
        asm volatile("s_waitcnt lgkmcnt(0)\n\ts_barrier" ::: "memory");
    }
    { auto rr = __builtin_amdgcn_permlane32_swap(__float_as_uint(lrun), __float_as_uint(lrun), false, false); lrun = __uint_as_float(rr[0]) + __uint_as_float(rr[1]); }
    if (hi == 0) wsf[32 + r32] = lrun;
    asm volatile("s_waitcnt lgkmcnt(0)" ::: "memory");
    bf16_t* Ow = J.O + (size_t)(b * NQ_PER_B + i0w) * PITCH;
    unsigned voff = (unsigned)(4 * hi * PITCH + r32); asm volatile("" : "+v"(voff));
#pragma unroll
    for (int r = 0; r < 16; ++r) { const float rl = __builtin_amdgcn_rcpf(wsf[32 + crow(r, hi)]);
#pragma unroll
        for (int c = 0; c < 4; ++c) { const unsigned w = cvtpk(o[c][r] * rl, 0.f); Ow[voff + (unsigned)(((r & 3) + 8 * (r >> 2)) * PITCH + 32 * c)] = (bf16_t)(w & 0xffffu); } }
    __syncthreads();
}
}
#ifndef MK_N_LAUNCHES
#define MK_N_LAUNCHES 1
#endif
constexpr int NWAVES = 8;
constexpr int NPHASE = 12;
constexpr int DM = 2048, NB = 4, SEQ = 2048, NMETA = 16, MTOK = NB * SEQ;
constexpr int DIN = 10248, NPROJ = 10240;
constexpr int KVB = 2112;
constexpr int NEXP = 32, TOPK = 4, DEXP = 2048, ECAP = 8192;
constexpr float RMS_EPS = 1e-5f, LOG2E = 1.4426950408889634f;
constexpr float QSCALE = 0.08838834764831845f * 1.4426950408889634f;
constexpr float LAMBDA_INIT = 0.2f;
constexpr size_t MiB = 1u << 20;
constexpr size_t WS_CTL = 0, CTL_ZERO_BYTES = 1 * MiB;
constexpr size_t WS_SMALL = 1 * MiB;
constexpr size_t WS_LOGF = 2 * MiB;
constexpr size_t WS_NB = 3 * MiB;
constexpr size_t WS_TOPI = 4 * MiB, WS_GATE = WS_TOPI + 256 * 1024, WS_RANK = WS_GATE + 256 * 1024;
constexpr size_t WS_WIN = 8 * MiB, WS_WBF = 48 * MiB, WS_WBD = 52 * MiB, WS_WOUT = 56 * MiB, WS_WGU = 64 * MiB, WS_WD = 576 * MiB;
constexpr size_t WS_XN = 832 * MiB, WS_QF = 866 * MiB, WS_KF = 882 * MiB, WS_VF = 899 * MiB, WS_QD = 916 * MiB, WS_KD = 932 * MiB, WS_VD = 949 * MiB;
constexpr size_t WS_GF = 966 * MiB, WS_GD = 998 * MiB, WS_OFOX = 1030 * MiB, WS_ODIFF = 1046 * MiB, WS_AD0 = 1062 * MiB, WS_AD1 = 1078 * MiB;
constexpr size_t WS_T1 = 1094 * MiB, WS_MERGED = 1126 * MiB, WS_H1 = 1158 * MiB, WS_XN2 = 1222 * MiB, WS_XS = 1254 * MiB, WS_ACT = 1766 * MiB, WS_YS = 2278 * MiB, WS_END = 3302 * MiB;
static_assert(WS_WIN + (size_t)NPROJ * DM * 2 <= WS_WBF && WS_WGU + (size_t)NEXP * 4096 * DM * 2 <= WS_WD && WS_WD + (size_t)NEXP * DM * DM * 2 <= WS_XN, "ws map (weights)");
static_assert(WS_XN + (size_t)(MTOK + 256) * DM * 2 <= WS_QF && WS_KF + (size_t)NB * KVB * 1024 * 2 <= WS_VF && WS_XS + (size_t)NEXP * ECAP * DM <= WS_ACT && WS_ACT + (size_t)NEXP * ECAP * DM <= WS_YS && WS_YS + (size_t)NEXP * ECAP * DM * 2 <= WS_END, "ws map (activations)");
constexpr int CW_BAR = 4096;
constexpr int CW_AQ = 8192;
constexpr int CW_ST = 16384;
constexpr int CW_CNT = 8448;
constexpr int RING_OFF = 0, RING_BYTES = 131072;
constexpr int P0_SCR = 16640;
constexpr int MOE_OFF = 135168;
constexpr int MOE_BYTES = 1024;
constexpr int MISC_OFF = MOE_OFF + MOE_BYTES;
constexpr int BGW_OFF = RING_BYTES;
constexpr int LDS_BYTES = 163840;
static_assert(MISC_OFF + 128 <= LDS_BYTES, "LDS map");

#define GAS __attribute__((address_space(1)))
#define LAS __attribute__((address_space(3)))
typedef unsigned short bf16;
typedef unsigned v4u __attribute__((ext_vector_type(4)));
typedef unsigned v2u __attribute__((ext_vector_type(2)));
typedef float f32x4 __attribute__((ext_vector_type(4)));
typedef float f32x16 __attribute__((ext_vector_type(16)));
typedef short bf16x8 __attribute__((ext_vector_type(8)));
typedef GAS unsigned gu32;
#define RLX_AGENT __ATOMIC_RELAXED, __HIP_MEMORY_SCOPE_AGENT
#define LDS_WAIT() asm volatile("s_waitcnt lgkmcnt(0)" ::: "memory")
#define VM_WAIT() asm volatile("s_waitcnt vmcnt(0)" ::: "memory")
__device__ __forceinline__ unsigned f2bf(float f) { unsigned u = __builtin_bit_cast(unsigned, f); return (u + 0x7fffu + ((u >> 16) & 1u)) >> 16; }
__device__ __forceinline__ unsigned pk2(float lo, float hi) { return f2bf(lo) | (f2bf(hi) << 16); }
__device__ __forceinline__ float bflo(unsigned w) { return __uint_as_float(w << 16); }
__device__ __forceinline__ float bfhi(unsigned w) { return __uint_as_float(w & 0xffff0000u); }

#define XB_TMO      128
#define XB_XCNT(j)  (256  + 64 * (j))
#define XB_XSUB(j)  (1280 + 64 * (j))
#define XB_XGEN(j)  (2304 + 64 * (j))
#define XB_TOP      3328
#define XB_TOPGEN   3392
#define XCD_BAR_WORDS 3456
#define XB_SPIN_CAP (1u << 18)

__device__ __forceinline__ unsigned xb_ld(unsigned* p)              { return __hip_atomic_load(p, __ATOMIC_RELAXED, __HIP_MEMORY_SCOPE_AGENT); }
__device__ __forceinline__ unsigned xb_add(unsigned* p, unsigned v) { return __hip_atomic_fetch_add(p, v, __ATOMIC_RELAXED, __HIP_MEMORY_SCOPE_AGENT); }
__device__ __forceinline__ unsigned xb_xcc_id() { return (unsigned)__builtin_amdgcn_s_getreg((3 << 11) | 20) & 0xFu; }
#define XB_SPIN(cond, bar) do { unsigned _sp = 0; while (cond) { __builtin_amdgcn_s_sleep(1); \
    if ((++_sp & 255u) == 0u) { if (xb_ld(&(bar)[XB_TMO])) break; if (_sp > XB_SPIN_CAP) { atomicAdd(&(bar)[XB_TMO], 1u); break; } } } } while (0)

struct XcdBarrier {
    unsigned* bar; unsigned x;
    volatile unsigned* st;
};

__device__ __forceinline__ XcdBarrier xcd_barrier_post(unsigned* bar, volatile unsigned* st) {
    XcdBarrier b; b.bar = bar; b.x = xb_xcc_id(); b.st = st;
    if (threadIdx.x == 0) (void)xb_add(&bar[XB_XCNT(b.x)], 1u);
    return b;
}
__device__ __forceinline__ void xcd_barrier_complete(unsigned* bar, unsigned x, unsigned& nloc, unsigned& nx) {
    const unsigned G = gridDim.x * gridDim.y * gridDim.z;
    unsigned sum, cnt, mine, sp = 0u;
    for (;;) {
        sum = 0u; cnt = 0u; mine = 0u;
#pragma unroll
        for (unsigned j = 0; j < 16; ++j) { const unsigned c = xb_ld(&bar[XB_XCNT(j)]); sum += c; cnt += (c > 0u) ? 1u : 0u; mine = (j == x) ? c : mine; }
        if (sum == G) break;
        __builtin_amdgcn_s_sleep(1);
        if ((++sp & 255u) == 0u) { if (xb_ld(&bar[XB_TMO])) break; if (sp > XB_SPIN_CAP) { atomicAdd(&bar[XB_TMO], 1u); break; } }
    }
    nloc = mine > 0u ? mine : 1u; nx = cnt > 0u ? cnt : 1u;
}

__device__ __forceinline__ void xcd_barrier(const XcdBarrier& b) {
    asm volatile("s_waitcnt vmcnt(0)" ::: "memory");
    __syncthreads();
    if (threadIdx.x == 0) {
        unsigned* bar = b.bar;
        __builtin_amdgcn_s_waitcnt(0);
        unsigned nloc = b.st[0], nx = b.st[1];
        if (nloc == 0u) { xcd_barrier_complete(bar, b.x, nloc, nx); b.st[0] = nloc; b.st[1] = nx; }
        const unsigned old = xb_add(&bar[XB_XSUB(b.x)], 1u);
        const unsigned gen = old / nloc;
        if (old + 1u == (gen + 1u) * nloc) {
            __builtin_amdgcn_fence(__ATOMIC_RELEASE, "agent");
            asm volatile("s_waitcnt vmcnt(0)" ::: "memory");
            const unsigned og = xb_add(&bar[XB_TOP], 1u);
            const unsigned tg = og / nx;
            if (og + 1u == (tg + 1u) * nx) xb_add(&bar[XB_TOPGEN], 1u);
            else XB_SPIN(xb_ld(&bar[XB_TOPGEN]) == tg, bar);
            __builtin_amdgcn_fence(__ATOMIC_ACQUIRE, "agent");
            xb_add(&bar[XB_XGEN(b.x)], 1u);
            asm volatile("s_waitcnt vmcnt(0)" ::: "memory");
        } else {
            XB_SPIN(xb_ld(&bar[XB_XGEN(b.x)]) == gen, bar);
            __builtin_amdgcn_fence(__ATOMIC_ACQUIRE, "agent");
            asm volatile("s_waitcnt vmcnt(0)" ::: "memory");
        }
    }
    __syncthreads();
}

__device__ __forceinline__ float wave_sum(float v) {
#pragma unroll
    for (int o = 1; o < 64; o <<= 1) v += __shfl_xor(v, o);
    return v;
}
struct TrB { const float* src; bf16* dst; int ldw, K; };
__device__ __forceinline__ TrB trb_make(const float* W, int ldw, int K, bf16* WT, int src_col0, int dst_row0, int kb, int lane) {
    const int nl = lane & 7, kq = lane >> 3; TrB t; t.ldw = ldw; t.K = K;
    t.src = W + (size_t)(64 * kb + 8 * kq) * ldw + src_col0 + 4 * nl; t.dst = WT + (size_t)(dst_row0 + 4 * nl) * K + 64 * kb + 8 * kq; return t;
}
__device__ __forceinline__ void trb_load(f32x4 (&v)[8], const TrB& t) {
#pragma unroll
    for (int r = 0; r < 8; ++r) v[r] = __builtin_nontemporal_load((const GAS f32x4*)(t.src + (size_t)r * t.ldw));
}
__device__ __forceinline__ void trb_store(const f32x4 (&v)[8], const TrB& t) {
#pragma unroll
    for (int j = 0; j < 4; ++j) { v4u o; o.x = pk2(v[0][j], v[1][j]); o.y = pk2(v[2][j], v[3][j]); o.z = pk2(v[4][j], v[5][j]); o.w = pk2(v[6][j], v[7][j]);
        *(GAS v4u*)(t.dst + (size_t)j * t.K) = o; }
}
struct TrItem { const float* src; unsigned char* dst; };
__device__ __forceinline__ void tr8_load(f32x4 (&v)[16], const float* src, int ldw) {
#pragma unroll
    for (int r = 0; r < 16; ++r) v[r] = __builtin_nontemporal_load((const GAS f32x4*)(src + (size_t)r * ldw));
}
__device__ __forceinline__ void tr8_store(const f32x4 (&v)[16], unsigned char* dst, int Kb, float scale) {
#pragma unroll
    for (int j = 0; j < 4; ++j) { v4u o;
        o.x = __builtin_amdgcn_cvt_pk_fp8_f32(v[2][j] * scale, v[3][j] * scale, __builtin_amdgcn_cvt_pk_fp8_f32(v[0][j] * scale, v[1][j] * scale, 0u, false), true);
        o.y = __builtin_amdgcn_cvt_pk_fp8_f32(v[6][j] * scale, v[7][j] * scale, __builtin_amdgcn_cvt_pk_fp8_f32(v[4][j] * scale, v[5][j] * scale, 0u, false), true);
        o.z = __builtin_amdgcn_cvt_pk_fp8_f32(v[10][j] * scale, v[11][j] * scale, __builtin_amdgcn_cvt_pk_fp8_f32(v[8][j] * scale, v[9][j] * scale, 0u, false), true);
        o.w = __builtin_amdgcn_cvt_pk_fp8_f32(v[14][j] * scale, v[15][j] * scale, __builtin_amdgcn_cvt_pk_fp8_f32(v[12][j] * scale, v[13][j] * scale, 0u, false), true);
        *(GAS v4u*)(dst + (size_t)j * Kb) = o; }
}
__device__ __forceinline__ TrItem tr8_item(int r, const float* w_gu, const float* w_dn, unsigned char* WGU8, unsigned char* WD8, int lane, int& ldw) {
    constexpr int I_GU = 16 * 128, I_DN = 16 * 64; TrItem t; const int nl = lane & 7, kq = lane >> 3;
    if (r < att::BG_E0 * I_GU) { const int e = r / I_GU, q = r % I_GU, kb = q / 128, n0 = 32 * (q % 128);
        const int drow = n0 < 2048 ? 256 * (n0 >> 7) + (n0 & 127) : 256 * ((n0 - 2048) >> 7) + 128 + (n0 & 127);
        ldw = 4096; t.src = w_gu + (size_t)e * DM * 4096 + (size_t)(128 * kb + 16 * kq) * 4096 + n0 + 4 * nl; t.dst = WGU8 + (size_t)e * 4096 * DM + (size_t)(drow + 4 * nl) * DM + 128 * kb + 16 * kq; }
    else { r -= att::BG_E0 * I_GU; const int e = r / I_DN, q = r % I_DN, kb = q / 64, n0 = 32 * (q % 64);
        ldw = DM; t.src = w_dn + (size_t)e * DM * DM + (size_t)(128 * kb + 16 * kq) * DM + n0 + 4 * nl; t.dst = WD8 + (size_t)e * DM * DM + (size_t)(n0 + 4 * nl) * DM + 128 * kb + 16 * kq; }
    return t;
}
__device__ __forceinline__ float log_sigmoid(float z) { return fminf(z, 0.f) - log1pf(expf(-fabsf(z))); }

struct Args { const float* in[22]; float* out; unsigned char* ws; int ph_lo, ph_hi; };

__device__ __forceinline__ void moe_tables(LAS int* mt, const gu32* ctl, int tid) {
    if (tid == 0) { int acc = 0;
        for (int e = 0; e < NEXP; ++e) { const int c = (int)__hip_atomic_load(ctl + CW_CNT + 32 * e, RLX_AGENT); const int n = (c + 255) >> 8; mt[e] = acc; mt[32 + e] = n; mt[128 + e] = c; acc += n; }
        mt[64] = acc; }
    __syncthreads();
}
__device__ __forceinline__ int moe_build_list(LAS int* mt, int nct, int G, int c, int tid) {
    LAS int* list = mt + 72;
    if (tid == 0) { const int T = mt[64], U = T * nct; int n = 0;
        const int R = U / G, Lv = U - R * G; const bool split = Lv > 0 && 2 * Lv <= G && (G & 15) == 0;
        for (int i = 0; i < 24; ++i) { long L = (long)i * G + c; int part = -1;
            if (split && i == R) { const int j = (c >> 4) * 8 + (c & 7); if (j >= Lv) break; part = (c >> 3) & 1; L = (long)R * G + j; }
            if (L >= U) break;
            int wg = (int)L; { const int q = U / 8, r = U % 8, xcd = wg % 8, off = wg / 8; wg = (xcd < r ? xcd * (q + 1) : r * (q + 1) + (xcd - r) * q) + off; }
            int e = 0; while (e < NEXP - 1 && wg >= (mt[e] + mt[32 + e]) * nct) ++e;
            const int local = wg - mt[e] * nct, ne = mt[32 + e]; const int tt = local % ne; int hf = (mt[128 + e] - 256 * tt <= 128) ? 1 : 0;
            if (part >= 0) { if (hf) { if (part == 1) break; } else hf = 1; }
            list[2 * n] = 2 * (e * (ECAP / 256) + tt) + (part == 1 ? 1 : 0); list[2 * n + 1] = (e * nct + local / ne) | (hf << 16); ++n; }
        mt[65] = n; }
    __syncthreads();
    return mt[65];
}

__global__ void __launch_bounds__(NWAVES * 64, 2) hyb_fwd(Args args) {
    extern __shared__ __attribute__((aligned(16))) unsigned char lds_raw[];
    LAS unsigned char* lds = (LAS unsigned char*)lds_raw;
    volatile LAS unsigned* MISC = (volatile LAS unsigned*)(lds + MISC_OFF);
    LAS int* mt = (LAS int*)(lds + MOE_OFF);
    const int tid = threadIdx.x, lane = tid & 63, wave = __builtin_amdgcn_readfirstlane(tid >> 6);
    const int G = gridDim.x, bx = blockIdx.x;
    const int vcu = (G % 8 == 0) ? (bx % 8) * (G / 8) + bx / 8 : bx;
    const int gw = vcu * NWAVES + wave, NGW = G * NWAVES;
    unsigned char* ws = args.ws;
    gu32* ctl = (gu32*)(ws + WS_CTL);
    const float* x = args.in[0]; const float* meta = args.in[1]; const float* relb = args.in[2]; const float* g_attn = args.in[3]; const float* w_in = args.in[4];
    const float* ffb = args.in[5]; const float* lq1 = args.in[6]; const float* lk1 = args.in[7]; const float* lq2 = args.in[8]; const float* lk2 = args.in[9];
    const float* subln = args.in[10]; const float* w_bf = args.in[11]; const float* w_bd = args.in[12]; const float* w_out = args.in[13]; const float* g_ffn = args.in[14];
    const float* w_router = args.in[15]; const float* b_router = args.in[16]; const float* w_gu = args.in[17]; const float* b_gu = args.in[18]; const float* w_dn = args.in[19];
    const float* b_dn = args.in[20]; const float* g_fin = args.in[21];
    float* TAB = (float*)(ws + WS_SMALL); float* LAMP = (float*)(ws + WS_SMALL + 2048); float* LOGFM = (float*)(ws + WS_SMALL + 4096);
    float* LOGF = (float*)(ws + WS_LOGF); float* NBIAS = (float*)(ws + WS_NB);
    int* TOPI = (int*)(ws + WS_TOPI); float* GATE = (float*)(ws + WS_GATE); int* RANK = (int*)(ws + WS_RANK);
    int* ROWTOK = (int*)(ws + WS_XS + 32 * MiB);
    bf16 *WIN = (bf16*)(ws + WS_WIN), *WBF = (bf16*)(ws + WS_WBF), *WBD = (bf16*)(ws + WS_WBD), *WOUT = (bf16*)(ws + WS_WOUT), *WGU = (bf16*)(ws + WS_WGU), *WD = (bf16*)(ws + WS_WD);
    unsigned char *WGU8 = ws + WS_WGU, *WD8 = ws + WS_WD, *XN28 = ws + WS_XN2, *XS8 = ws + WS_XS, *ACT8 = ws + WS_ACT;
    bf16 *XN = (bf16*)(ws + WS_XN), *QF = (bf16*)(ws + WS_QF), *KF = (bf16*)(ws + WS_KF), *VF = (bf16*)(ws + WS_VF), *QD = (bf16*)(ws + WS_QD), *KD = (bf16*)(ws + WS_KD), *VD = (bf16*)(ws + WS_VD);
    bf16 *GF = (bf16*)(ws + WS_GF), *GD = (bf16*)(ws + WS_GD), *OFOX = (bf16*)(ws + WS_OFOX), *AD0 = (bf16*)(ws + WS_AD0), *AD1 = (bf16*)(ws + WS_AD1), *ODIFF = (bf16*)(ws + WS_ODIFF);
    bf16 *T1 = (bf16*)(ws + WS_T1), *MERGED = (bf16*)(ws + WS_MERGED), *XN2 = (bf16*)(ws + WS_XN2), *XS = (bf16*)(ws + WS_XS), *ACT = (bf16*)(ws + WS_ACT); unsigned char* YS = ws + WS_YS;
    float* H1 = (float*)(ws + WS_H1);

    for (int u = tid; u < (LDS_BYTES - MOE_OFF) / 4; u += NWAVES * 64) ((LAS unsigned*)(lds + MOE_OFF))[u] = 0u;
    __syncthreads();
    XcdBarrier bar; bar.bar = (unsigned*)(ctl + CW_BAR); bar.x = 0; bar.st = nullptr;
    if (MK_N_LAUNCHES == 1) bar = xcd_barrier_post((unsigned*)(ctl + CW_BAR), (volatile unsigned*)(ctl + CW_ST + 2 * bx));
    const int lo = args.ph_lo, hi = args.ph_hi;
#ifndef PHMASK
#define PHMASK 0xFFF
#endif
#define IN(k) (((PHMASK >> (k)) & 1) && lo <= (k) && (k) < hi)
#ifndef REPMASK
#define REPMASK 0
#endif
#define REPS(k) ((((REPMASK) >> (k)) & 1) ? 2 : 1)
#define SEAM(k) do { if (IN(k) && IN((k) + 1)) xcd_barrier(bar); } while (0)

    if (IN(0)) for (int rep_ = 0; rep_ < REPS(0); ++rep_) { if (rep_) xcd_barrier(bar);
        int tid_o = threadIdx.x; asm volatile("" : "+v"(tid_o)); const int tid = tid_o, lane = tid_o & 63;
        LAS float* scr = (LAS float*)(lds + RING_OFF + wave * P0_SCR);
        LAS float* wff = (LAS float*)(lds + RING_OFF);
        { float tw[32];
#pragma unroll
          for (int q = 0; q < 32; ++q) { const int i = tid + q * NWAVES * 64; tw[q] = w_in[(size_t)(i >> 3) * DIN + 3072 + (i & 7)]; }
#pragma unroll
          for (int q = 0; q < 32; ++q) { const int i = tid + q * NWAVES * 64; wff[(i & 7) * DM + (i >> 3)] = tw[q]; } }
        __syncthreads();
        constexpr int I_IN = 32 * (NPROJ / 32), I_BF = 16 * 64, I_OUT = 32 * 64;
        constexpr int NITEMS = I_IN + 2 * I_BF + I_OUT;
#define TRB_ITEM(it_) ((it_) < I_IN ? trb_make(w_in, DIN, DM, WIN, (32 * ((it_) % (NPROJ / 32))) < 3072 ? 32 * ((it_) % (NPROJ / 32)) : 32 * ((it_) % (NPROJ / 32)) + 8, 32 * ((it_) % (NPROJ / 32)), (it_) / (NPROJ / 32), lane) \
        : (it_) < I_IN + I_BF ? trb_make(w_bf, DM, 1024, WBF, 32 * (((it_) - I_IN) % 64), 32 * (((it_) - I_IN) % 64), ((it_) - I_IN) / 64, lane) \
        : (it_) < I_IN + 2 * I_BF ? trb_make(w_bd, DM, 1024, WBD, 32 * (((it_) - I_IN - I_BF) % 64), 32 * (((it_) - I_IN - I_BF) % 64), ((it_) - I_IN - I_BF) / 64, lane) \
        : trb_make(w_out, DM, DM, WOUT, 32 * (((it_) - I_IN - 2 * I_BF) % 64), 32 * (((it_) - I_IN - 2 * I_BF) % 64), ((it_) - I_IN - 2 * I_BF) / 64, lane))
        { f32x4 va[8], vb[8]; TrB ta, tb; int it = gw;
          if (it < NITEMS) { ta = TRB_ITEM(it); trb_load(va, ta); }
          while (it < NITEMS) {
              const int it1 = it + NGW; if (it1 < NITEMS) { tb = TRB_ITEM(it1); trb_load(vb, tb); }
              trb_store(va, ta);
              if (it1 >= NITEMS) break;
              const int it2 = it1 + NGW; if (it2 < NITEMS) { ta = TRB_ITEM(it2); trb_load(va, ta); }
              trb_store(vb, tb);
              it = it2; } }
#undef TRB_ITEM
        { const int ROWS_END = MTOK + NMETA; int m = gw < MTOK ? gw : ROWS_END; f32x4 v[8], vn[8], gA[8]; const float ffbv = ffb[lane & 7];
#pragma unroll
          for (int j = 0; j < 8; ++j) gA[j] = *((const GAS f32x4*)g_attn + 64 * j + lane);
          if (m < ROWS_END) { const GAS f32x4* xr = (const GAS f32x4*)(x + (size_t)m * DM) + lane;
#pragma unroll
              for (int j = 0; j < 8; ++j) v[j] = xr[64 * j]; }
          while (m < ROWS_END) {
            int mn = ROWS_END;
            if (m < MTOK) { mn = m + NGW; if (mn >= MTOK) mn = (gw >= 64 && gw < 64 + NMETA) ? MTOK + gw - 64 : ROWS_END; }
            if (mn < ROWS_END) { const GAS f32x4* xr = (const GAS f32x4*)((mn < MTOK) ? x + (size_t)mn * DM : meta + (size_t)(mn - MTOK) * DM) + lane;
#pragma unroll
                for (int j = 0; j < 8; ++j) vn[j] = xr[64 * j]; }
            float ss = 0.f;
#pragma unroll
            for (int j = 0; j < 8; ++j) ss += (v[j].x * v[j].x + v[j].y * v[j].y) + (v[j].z * v[j].z + v[j].w * v[j].w);
            const float rstd = rsqrtf(wave_sum(ss) * (1.f / DM) + RMS_EPS);
            float ff[8];
#pragma unroll
            for (int h = 0; h < 8; ++h) ff[h] = 0.f;
            GAS v2u* o8 = (GAS v2u*)(XN + (size_t)m * DM) + lane;
#pragma unroll
            for (int j = 0; j < 8; ++j) { const f32x4 yv = v[j] * rstd * gA[j];
                v2u w; w.x = pk2(yv.x, yv.y); w.y = pk2(yv.z, yv.w); o8[64 * j] = w;
#pragma unroll
                for (int h = 0; h < 8; ++h) { const f32x4 w4 = *(const LAS f32x4*)(wff + h * DM + 256 * j + 4 * lane); ff[h] += (yv.x * w4.x + yv.y * w4.y) + (yv.z * w4.z + yv.w * w4.w); }
                asm volatile("" ::: "memory"); }
            float r4[4], r2[2], r1;
            { const bool b0 = lane & 1;
#pragma unroll
              for (int i = 0; i < 4; ++i) { const float keep = b0 ? ff[2 * i + 1] : ff[2 * i], send = b0 ? ff[2 * i] : ff[2 * i + 1]; r4[i] = keep + __shfl_xor(send, 1); }
              const bool b1 = lane & 2;
#pragma unroll
              for (int i = 0; i < 2; ++i) { const float keep = b1 ? r4[2 * i + 1] : r4[2 * i], send = b1 ? r4[2 * i] : r4[2 * i + 1]; r2[i] = keep + __shfl_xor(send, 2); }
              const bool b2 = lane & 4; const float keep = b2 ? r2[1] : r2[0], send = b2 ? r2[0] : r2[1]; r1 = keep + __shfl_xor(send, 4);
              r1 += __shfl_xor(r1, 8); r1 += __shfl_xor(r1, 16); r1 += __shfl_xor(r1, 32); }
            if (lane < 8) { const float lf = log_sigmoid(r1 + ffbv); if (m < MTOK) LOGF[(size_t)m * 8 + lane] = lf; else LOGFM[(m - MTOK) * 8 + lane] = lf; }
#pragma unroll
            for (int j = 0; j < 8; ++j) v[j] = vn[j];
            m = mn; } }
        if (vcu == G - 1) {
            { const int i = tid, h = i >> 7, d = i & 127; int bk;
                if (d < 16) bk = d; else { const float lp = logf((float)d / 16.0f) / 2.0794415416798357f; bk = 16 + (int)(lp * 16.0f); bk = bk > 31 ? 31 : bk; }
                TAB[i] = relb[bk * 4 + h] * LOG2E; }
          if (wave == 0) {
            float s1 = lq1[lane] * lk1[lane] + lq1[lane + 64] * lk1[lane + 64], s2 = lq2[lane] * lk2[lane] + lq2[lane + 64] * lk2[lane + 64];
            s1 = wave_sum(s1); s2 = wave_sum(s2);
            if (lane == 0) LAMP[0] = expf(s1) - expf(s2) + LAMBDA_INIT; }
        }
        for (int i = gw; i < 4 * NB * 48; i += NGW) { const int bufi = i / (NB * 48), rr = i % (NB * 48), b = rr / 48, kv = 16 + rr % 48;
            bf16* base = bufi == 0 ? KF : bufi == 1 ? VF : bufi == 2 ? KD : VD; GAS v4u* p = (GAS v4u*)(base + (size_t)(b * KVB + kv) * 1024);
            p[lane] = (v4u){0u, 0u, 0u, 0u}; p[lane + 64] = (v4u){0u, 0u, 0u, 0u}; }
    }
    SEAM(0);

    if (IN(1)) for (int rep_ = 0; rep_ < REPS(1); ++rep_) { if (rep_) xcd_barrier(bar);
        int tid_o = threadIdx.x; asm volatile("" : "+v"(tid_o)); const int tid = tid_o, lane = tid_o & 63;
        for (int job = bx; job < 96; job += G) {
            if (job < 64) {
                const int q0 = 64 * job; f32x4 acc[4];
#pragma unroll
                for (int nb = 0; nb < 4; ++nb) acc[nb] = (f32x4){0.f, 0.f, 0.f, 0.f};
                const bf16* ap = XN + (size_t)(MTOK + (lane & 15)) * DM + 256 * wave + 8 * (lane >> 4);
#pragma unroll
                for (int st = 0; st < 8; ++st) { const bf16x8 a = *(const bf16x8*)(ap + 32 * st);
#pragma unroll
                    for (int nb = 0; nb < 4; ++nb) { const int q = q0 + 16 * nb + (lane & 15); const int wrow = q < 2048 ? 1024 + q : 2048 + q;
                        const bf16x8 bq = *(const bf16x8*)(WIN + (size_t)wrow * DM + 256 * wave + 32 * st + 8 * (lane >> 4));
                        acc[nb] = __builtin_amdgcn_mfma_f32_16x16x32_bf16(a, bq, acc[nb], 0, 0, 0); } }
                LAS float* part = (LAS float*)(lds + RING_OFF);
#pragma unroll
                for (int nb = 0; nb < 4; ++nb)
#pragma unroll
                    for (int r = 0; r < 4; ++r) part[(wave * 16 + (lane >> 4) * 4 + r) * 64 + 16 * nb + (lane & 15)] = acc[nb][r];
                __syncthreads();
                for (int idx = tid; idx < 1024; idx += NWAVES * 64) { const int row = idx >> 6, col = idx & 63; float s = 0.f;
#pragma unroll
                    for (int w = 0; w < 8; ++w) s += part[(w * 16 + row) * 64 + col];
                    const int q = q0 + col; bf16* base = q < 1024 ? KF : q < 2048 ? VF : q < 3072 ? KD : VD; const bf16 hv = (bf16)f2bf(s);
#pragma unroll
                    for (int b = 0; b < NB; ++b) base[(size_t)(b * KVB + row) * 1024 + (q & 1023)] = hv; }
                __syncthreads();
            } else if (wave == 0) {
                const int b = (job - 64) >> 3, h = (job - 64) & 7; float* nbp = NBIAS + (size_t)(b * 8 + h) * KVB; float v[33];
#pragma unroll
                for (int ch = 0; ch < 33; ++ch) { const int p = 64 * ch + lane; v[ch] = 0.f;
                    if (p < NMETA) v[ch] = LOGFM[p * 8 + h]; else if (p < NMETA + SEQ) v[ch] = LOGF[(size_t)(b * SEQ + p - NMETA) * 8 + h]; }
                float carry = 0.f;
#pragma unroll
                for (int ch = 0; ch < 33; ++ch) { const int p = 64 * ch + lane; float x = v[ch];
#pragma unroll
                    for (int o = 1; o < 64; o <<= 1) { const float t = __shfl_up(x, o); if (lane >= o) x += t; }
                    x += carry;
                    if (p < NMETA + SEQ) nbp[p < NMETA ? p : p + 48] = -x * LOG2E;
                    carry = __shfl(x, 63); }
                if (lane >= 16) nbp[lane] = 0.f;
            }
        }
        __syncthreads();
        pg8::Gemm g{XN, WIN, MTOK, NPROJ, DM}; pg8::StaticOrder S; S.init(MTOK, NPROJ, G, bx);
        pg8::EpiInProj E{QF, KF, VF, QD, KD, VD, GF, GD, QSCALE};
        pg8::BgW bgw{w_gu, w_dn, WGU8, WD8, bx, 1024 * att::BG_E0 + 16384, G, -1, pg8::W8_SCALE, 1024 * att::BG_E0, pg8::BGW_GU - 1024 * att::BG_E0};
        pg8::gemm_phase<pg8::EpiInProj, pg8::StaticOrder, true, true, false, 0>(lds + RING_OFF, g, S, E, &bgw);
    }
    SEAM(1);

    if (IN(2)) for (int rep_ = 0; rep_ < REPS(2); ++rep_) { if (rep_) xcd_barrier(bar);
        int tid_o = threadIdx.x; asm volatile("" : "+v"(tid_o)); const int tid = tid_o, lane = tid_o & 63;
        LAS int* qslot = (LAS int*)(lds + RING_OFF + att::L_Q);
        att::Bg bg; { const int total = (NEXP - att::BG_E0) * att::BG_PER_E; bg.w = w_gu; bg.w8 = WGU8; bg.pos = bx; bg.end = total; bg.stride = G; bg.scale = pg8::W8_SCALE; if (rep_) bg.end = 0; }
        for (;;) {
            if (tid == 0) *qslot = (int)__hip_atomic_fetch_add(ctl + CW_AQ + 64 * rep_, 1u, RLX_AGENT);
            __syncthreads();
            const int u = __builtin_amdgcn_readfirstlane(*qslot);
            __syncthreads();
            if (u >= 768) break;
            const int qb = 7 - u / 96, rem = u % 96, jb = rem >> 2, b = rem & 3;
            att::Job J;
            if (jb < 8) { J.Q = QF + jb * 128; J.K = KF + jb * 128; J.V = VF + jb * 128; J.O = OFOX + jb * 128; J.nb = NBIAS + (size_t)jb * KVB; J.tab = TAB; J.fox = 1; }
            else { const int d = jb - 8, h = d >> 2, mp = (d >> 1) & 1, vh = d & 1;
                J.Q = QD + h * 256 + mp * 128; J.K = KD + h * 256 + mp * 128; J.V = VD + h * 256 + vh * 128; J.O = (mp ? AD1 : AD0) + h * 256 + vh * 128; J.nb = NBIAS; J.tab = TAB + h * 128; J.fox = 0; }
            if (jb < 8) J.nb += (size_t)b * 7 * KVB;
            att::attn_unit((LAS char*)(lds + RING_OFF), J, b, qb, bg);
        }
        while (bg.pos < bg.end) { att::bg_issue(bg, (LAS char*)(lds + RING_OFF), wave, lane); att::bg_consume(bg, (LAS char*)(lds + RING_OFF), wave, lane); bg.pos += bg.stride; asm volatile("s_waitcnt lgkmcnt(0)" ::: "memory"); }
    }
    SEAM(2);

    if (IN(3)) for (int rep_ = 0; rep_ < REPS(3); ++rep_) { if (rep_) xcd_barrier(bar);
        int tid_o = threadIdx.x; asm volatile("" : "+v"(tid_o)); const int tid = tid_o, lane = tid_o & 63;
        const float lam = LAMP[0];
        const int sub = lane & 15;
        f32x4 sl[4];
#pragma unroll
        for (int i = 0; i < 4; ++i) sl[i] = *(const f32x4*)(subln + sub * 16 + 4 * i);
        for (int m = gw; m < MTOK; m += NGW) {
            const size_t off = (size_t)m * 1024 + lane * 16;
            const v4u a0 = *(const GAS v4u*)(AD0 + off), a1 = *(const GAS v4u*)(AD0 + off + 8), c0 = *(const GAS v4u*)(AD1 + off), c1 = *(const GAS v4u*)(AD1 + off + 8);
            float a[16];
#pragma unroll
            for (int i = 0; i < 4; ++i) { a[2 * i] = bflo(a0[i]) - lam * bflo(c0[i]); a[2 * i + 1] = bfhi(a0[i]) - lam * bfhi(c0[i]); a[8 + 2 * i] = bflo(a1[i]) - lam * bflo(c1[i]); a[8 + 2 * i + 1] = bfhi(a1[i]) - lam * bfhi(c1[i]); }
            float ss = 0.f;
#pragma unroll
            for (int i = 0; i < 16; ++i) ss += a[i] * a[i];
            ss += __shfl_xor(ss, 1); ss += __shfl_xor(ss, 2); ss += __shfl_xor(ss, 4); ss += __shfl_xor(ss, 8);
            const float rs = rsqrtf(ss * (1.f / 256.f) + RMS_EPS) * (1.0f - LAMBDA_INIT);
            v4u o0, o1;
#pragma unroll
            for (int i = 0; i < 4; ++i) { o0[i] = pk2(a[2 * i] * rs * sl[i >> 1][(2 * i) & 3], a[2 * i + 1] * rs * sl[i >> 1][(2 * i + 1) & 3]);
                                          o1[i] = pk2(a[8 + 2 * i] * rs * sl[2 + (i >> 1)][(2 * i) & 3], a[8 + 2 * i + 1] * rs * sl[2 + (i >> 1)][(2 * i + 1) & 3]); }
            *(GAS v4u*)(ODIFF + off) = o0; *(GAS v4u*)(ODIFF + off + 8) = o1;
        }
    }
    SEAM(3);

    if (IN(4)) for (int rep_ = 0; rep_ < REPS(4); ++rep_) { if (rep_) xcd_barrier(bar);
        int tid_o = threadIdx.x; asm volatile("" : "+v"(tid_o)); const int tid = tid_o, lane = tid_o & 63;
        pg8::Gemm g{OFOX, WBF, 2 * MTOK, 2 * DM, 1024}; pg8::PairOrder S; S.S.init(MTOK, DM, G, bx);
        pg8::EpiGate2 E{GF, GD, T1, MERGED};
        pg8::gemm_phase<pg8::EpiGate2, pg8::PairOrder, true, true>(lds + RING_OFF, g, S, E);
    }
    SEAM(4);
    if (IN(5)) { }
    if (IN(6)) for (int rep_ = 0; rep_ < REPS(6); ++rep_) { if (rep_) xcd_barrier(bar);
        int tid_o = threadIdx.x; asm volatile("" : "+v"(tid_o)); const int tid = tid_o, lane = tid_o & 63;
        pg8::Gemm g{MERGED, WOUT, MTOK, DM, DM}; pg8::StaticOrder S; S.init(MTOK, DM, G, bx);
        pg8::EpiResF32 E{x, H1};
        pg8::gemm_phase<pg8::EpiResF32, pg8::StaticOrder, true, true>(lds + RING_OFF, g, S, E);
    }
    SEAM(6);

    if (IN(7)) for (int rep_ = 0; rep_ < REPS(7); ++rep_) { if (rep_) xcd_barrier(bar);
        int tid_o = threadIdx.x; asm volatile("" : "+v"(tid_o)); const int tid = tid_o, lane = tid_o & 63;
        LAS float* part = (LAS float*)(lds + RING_OFF);
        LAS float* lg = (LAS float*)(lds + RING_OFF + 32768);
        LAS float* rs = (LAS float*)(lds + RING_OFF + 40960);
        LAS int* hist = (LAS int*)(lds + RING_OFF + 41216);
        LAS int* gbase = (LAS int*)(lds + RING_OFF + 41472);
        LAS int* sel = (LAS int*)(lds + RING_OFF + 41728);
        LAS int* lrank = (LAS int*)(lds + RING_OFF + 42240);
        for (int it = bx; it < MTOK / 32; it += G) {
            const int t0 = 32 * it;
            if (tid < 32) hist[tid] = 0;
            LAS unsigned* xst = (LAS unsigned*)(lds + RING_OFF + 49152);
            { f32x4 v[8], vn[8];
              { const GAS f32x4* xr = (const GAS f32x4*)(H1 + (size_t)(t0 + 4 * wave) * DM) + lane;
#pragma unroll
                for (int j = 0; j < 8; ++j) v[j] = xr[64 * j]; }
#pragma unroll 1
              for (int i = 0; i < 4; ++i) {
                if (i < 3) { const GAS f32x4* xr = (const GAS f32x4*)(H1 + (size_t)(t0 + 4 * wave + i + 1) * DM) + lane;
#pragma unroll
                    for (int j = 0; j < 8; ++j) vn[j] = xr[64 * j]; }
                float ss = 0.f;
#pragma unroll
                for (int j = 0; j < 8; ++j) ss += (v[j].x * v[j].x + v[j].y * v[j].y) + (v[j].z * v[j].z + v[j].w * v[j].w);
                const float rstd = rsqrtf(wave_sum(ss) * (1.f / DM) + RMS_EPS);
                LAS unsigned* xw = xst + (4 * wave + i) * 512 + lane;
#pragma unroll
                for (int j = 0; j < 8; ++j) { const f32x4 g = *((const GAS f32x4*)g_ffn + 64 * j + lane); const f32x4 yv = v[j] * (rstd * pg8::X8_SCALE) * g; xw[64 * j] = pg8::pk4_fp8(yv.x, yv.y, yv.z, yv.w); }
                if (lane == 0) rs[4 * wave + i] = rstd;
#pragma unroll
                for (int j = 0; j < 8; ++j) v[j] = vn[j]; } }
            { f32x16 acc;
#pragma unroll
              for (int r = 0; r < 16; ++r) acc[r] = 0.f;
              const int kk = lane >> 5, col = lane & 31; const float* ap = H1 + (size_t)(t0 + col) * DM + 256 * wave + kk; const float* bp = w_router + (size_t)(256 * wave + kk) * NEXP + col; const float* gp = g_ffn + 256 * wave + kk;
#pragma unroll 8
              for (int s = 0; s < 128; ++s) { const float a = ap[2 * s]; const float bw = bp[(size_t)2 * s * NEXP] * gp[2 * s]; acc = __builtin_amdgcn_mfma_f32_32x32x2f32(a, bw, acc, 0, 0, 0); }
#pragma unroll
              for (int r = 0; r < 16; ++r) part[(wave * 32 + ((r & 3) + 8 * (r >> 2) + 4 * kk)) * 32 + col] = acc[r]; }
            __syncthreads();
            for (int idx = tid; idx < 1024; idx += NWAVES * 64) { const int tok = idx >> 5, e = idx & 31; float s = 0.f;
#pragma unroll
                for (int w = 0; w < 8; ++w) s += part[(w * 32 + tok) * 32 + e];
                lg[tok * 33 + e] = s * rs[tok] + b_router[e]; }
            __syncthreads();
            if (tid < 32) { const int tok = tid; float v[4]; int ix[4]; unsigned used = 0u;
#pragma unroll
                for (int k = 0; k < 4; ++k) { float best = -__builtin_inff(); int bi = 0;
                    for (int e = 0; e < NEXP; ++e) { const float z = lg[tok * 33 + e]; if (!((used >> e) & 1u) && z > best) { best = z; bi = e; } }
                    used |= 1u << bi; v[k] = best; ix[k] = bi; }
                const float e1 = expf(v[1] - v[0]), e2 = expf(v[2] - v[0]), e3 = expf(v[3] - v[0]); const float inv = 1.0f / (1.0f + e1 + e2 + e3);
                const float gt[4] = {inv, e1 * inv, e2 * inv, e3 * inv};
#pragma unroll
                for (int k = 0; k < 4; ++k) { TOPI[(size_t)(t0 + tok) * 4 + k] = ix[k]; GATE[(size_t)(t0 + tok) * 4 + k] = gt[k]; sel[tok * 4 + k] = ix[k]; lrank[tok * 4 + k] = __hip_atomic_fetch_add(hist + ix[k], 1, __ATOMIC_RELAXED, __HIP_MEMORY_SCOPE_WORKGROUP); } }
            __syncthreads();
            if (tid < 32) { const int c = hist[tid]; gbase[tid] = c ? (int)__hip_atomic_fetch_add(ctl + CW_CNT + 32 * tid, (unsigned)c, RLX_AGENT) : 0; }
            __syncthreads();
            if (tid < 128) RANK[(size_t)t0 * 4 + tid] = gbase[sel[tid]] + lrank[tid];
            if (tid < 128) ROWTOK[(size_t)sel[tid] * ECAP + gbase[sel[tid]] + lrank[tid]] = t0 + (tid >> 2);
#pragma unroll 1
            for (int i = 0; i < 4; ++i) { const LAS v4u* xs = (const LAS v4u*)(xst + (4 * wave + i) * 512) + lane; const v4u a = xs[0], b = xs[64];
                GAS v4u* o = (GAS v4u*)(XS8 + (size_t)(t0 + 4 * wave + i) * DM) + lane; o[0] = a; o[64] = b; }
            __syncthreads();
        }
    }
    SEAM(7);

    if (IN(8)) { }

    if (IN(9)) for (int rep_ = 0; rep_ < REPS(9); ++rep_) { if (rep_) xcd_barrier(bar);
        int tid_o = threadIdx.x; asm volatile("" : "+v"(tid_o)); const int tid = tid_o, lane = tid_o & 63;
        moe_tables(mt, ctl, tid);
        const int n = moe_build_list(mt, 16, G, bx, tid);
        LAS int* tokl = (LAS int*)(lds + MOE_OFF + 2048);
        for (int idx = tid; idx < 256 * n; idx += NWAVES * 64) { const int ui = idx >> 8, r = idx & 255; const int rr = 128 * mt[72 + 2 * ui] + r, e = (mt[72 + 2 * ui + 1] & 0xffff) >> 4;
            const int tok = (rr - e * ECAP < mt[128 + e]) ? ROWTOK[rr] : 0; tokl[idx] = tok * DM; }
        __syncthreads();
        pg8::Gemm g{(const bf16*)XS8, (const bf16*)WGU8, 0, 0, DM / 2}; pg8::ListOrder S{(const LAS int*)(mt + 72), n, tokl};
        pg8::EpiSwiglu E{b_gu, ACT8};
        pg8::gemm_phase<pg8::EpiSwiglu, pg8::ListOrder, true, true, true, -1, true>(lds + RING_OFF, g, S, E);
    }
    SEAM(9);
    if (IN(10)) for (int rep_ = 0; rep_ < REPS(10); ++rep_) { if (rep_) xcd_barrier(bar);
        int tid_o = threadIdx.x; asm volatile("" : "+v"(tid_o)); const int tid = tid_o, lane = tid_o & 63;
        moe_tables(mt, ctl, tid);
        const int n = moe_build_list(mt, 8, G, bx, tid);
        pg8::Gemm g{(const bf16*)ACT8, (const bf16*)WD8, 0, 0, DM / 2}; pg8::ListOrder S{(const LAS int*)(mt + 72), n};
        pg8::EpiDown E{b_dn, YS};
        pg8::gemm_phase<pg8::EpiDown, pg8::ListOrder, true, true, true>(lds + RING_OFF, g, S, E);
    }
    SEAM(10);

    if (IN(11)) for (int rep_ = 0; rep_ < REPS(11); ++rep_) { if (rep_) xcd_barrier(bar);
        int tid_o = threadIdx.x; asm volatile("" : "+v"(tid_o)); const int tid = tid_o, lane = tid_o & 63;
        { int m = gw; f32x4 v[8], vn[8]; int dst[4], dstn[4]; float gt[4], gtn[4];
#define P11_FETCH(mm_, vv_, dd_, gg_) do { const GAS f32x4* hr_ = (const GAS f32x4*)(H1 + (size_t)(mm_) * DM) + lane; \
            _Pragma("unroll") for (int j = 0; j < 8; ++j) vv_[j] = hr_[64 * j]; \
            _Pragma("unroll") for (int k = 0; k < 4; ++k) { dd_[k] = __builtin_amdgcn_readfirstlane(TOPI[(size_t)(mm_) * 4 + k]) * ECAP + __builtin_amdgcn_readfirstlane(RANK[(size_t)(mm_) * 4 + k]); gg_[k] = GATE[(size_t)(mm_) * 4 + k]; } } while (0)
          if (m < MTOK) P11_FETCH(m, v, dst, gt);
          while (m < MTOK) {
            const int mn = m + NGW;
            unsigned ys[4][8];
#pragma unroll
            for (int k = 0; k < 4; ++k) { const GAS unsigned* yr = (const GAS unsigned*)(YS + (size_t)dst[k] * DM) + lane;
#pragma unroll
                for (int j = 0; j < 8; ++j) ys[k][j] = yr[64 * j]; }
            if (mn < MTOK) P11_FETCH(mn, vn, dstn, gtn);
#pragma unroll
            for (int k = 0; k < 4; ++k)
#pragma unroll
                for (int j = 0; j < 8; ++j) { const unsigned w = ys[k][j]; const auto lo = __builtin_amdgcn_cvt_pk_f32_fp8(w, false), hi2 = __builtin_amdgcn_cvt_pk_f32_fp8(w, true); const float gk = gt[k] * (1.0f / pg8::Y8_SCALE);
                    v[j].x += gk * lo[0]; v[j].y += gk * lo[1]; v[j].z += gk * hi2[0]; v[j].w += gk * hi2[1]; }
            float ss = 0.f;
#pragma unroll
            for (int j = 0; j < 8; ++j) ss += (v[j].x * v[j].x + v[j].y * v[j].y) + (v[j].z * v[j].z + v[j].w * v[j].w);
            const float rstd = rsqrtf(wave_sum(ss) * (1.f / DM) + RMS_EPS);
            GAS f32x4* orow = (GAS f32x4*)(args.out + (size_t)m * DM) + lane;
#pragma unroll
            for (int j = 0; j < 8; ++j) { const f32x4 g = *((const GAS f32x4*)g_fin + 64 * j + lane); orow[64 * j] = v[j] * rstd * g; }
#pragma unroll
            for (int j = 0; j < 8; ++j) v[j] = vn[j];
#pragma unroll
            for (int k = 0; k < 4; ++k) { dst[k] = dstn[k]; gt[k] = gtn[k]; }
            m = mn; }
#undef P11_FETCH
        }
    }
#undef IN
#undef SEAM
}

extern "C" void kernel_launch(void* const* d_in, const int* in_sizes, int n_in, void* d_out, int out_size, void* d_ws, size_t ws_size, hipStream_t stream) {
    static int grid = 0;
    if (grid == 0) {
        if (n_in != 22 || in_sizes[0] != MTOK * DM || out_size != MTOK * DM || ws_size < WS_END) { fprintf(stderr, "kernel_launch: unexpected shapes (n_in %d, in0 %d, out %d, ws %zu); nothing launched\n", n_in, n_in > 0 ? in_sizes[0] : -1, out_size, ws_size); grid = -1; return; }
        int dev = 0, cus = 0, per_cu = 0;
        if (hipGetDevice(&dev) != hipSuccess || hipDeviceGetAttribute(&cus, hipDeviceAttributeMultiprocessorCount, dev) != hipSuccess) { fprintf(stderr, "kernel_launch: device query failed\n"); grid = -1; return; }
        if (hipFuncSetAttribute((const void*)hyb_fwd, hipFuncAttributeMaxDynamicSharedMemorySize, LDS_BYTES) != hipSuccess) { fprintf(stderr, "kernel_launch: hipFuncSetAttribute failed\n"); grid = -1; return; }
        if (hipOccupancyMaxActiveBlocksPerMultiprocessor(&per_cu, (const void*)hyb_fwd, NWAVES * 64, LDS_BYTES) != hipSuccess || per_cu < 1) fprintf(stderr, "kernel_launch: note: occupancy query reports %d workgroups per CU\n", per_cu);
        (void)hipGetLastError();
        grid = cus;
    }
    if (grid < 0) return;
    if (hipMemsetAsync((char*)d_ws + WS_CTL, 0, CTL_ZERO_BYTES, stream) != hipSuccess) { fprintf(stderr, "kernel_launch: memset failed\n"); return; }
    Args a{};
    for (int i = 0; i < 22; ++i) a.in[i] = (const float*)d_in[i];
    a.out = (float*)d_out; a.ws = (unsigned char*)d_ws;
#if MK_N_LAUNCHES == 1
    a.ph_lo = 0; a.ph_hi = NPHASE;
    hipLaunchKernelGGL(hyb_fwd, dim3(grid), dim3(NWAVES * 64), LDS_BYTES, stream, a);
#else
    for (int p = 0; p < NPHASE; ++p) { a.ph_lo = p; a.ph_hi = p + 1; hipLaunchKernelGGL(hyb_fwd, dim3(grid), dim3(NWAVES * 64), LDS_BYTES, stream, a); }
#endif
    const hipError_t le = hipPeekAtLastError();
    if (le != hipSuccess) fprintf(stderr, "kernel_launch: launch failed: %s\n", hipGetErrorName(le));
}
```

```cpp
#include <hip/hip_runtime.h>
#include <cstdio>
#include <cstdint>
namespace pg8 {
#define PG8_LAS __attribute__((address_space(3)))
typedef unsigned short bf16_t;
typedef short bf16x8 __attribute__((ext_vector_type(8)));
typedef float f32x4 __attribute__((ext_vector_type(4)));
typedef unsigned u32x4 __attribute__((ext_vector_type(4)));
typedef int v4i32 __attribute__((ext_vector_type(4)));
typedef int v8i32 __attribute__((ext_vector_type(8)));
constexpr int BM = 256, BK = 64, HALF = 128, HTB = HALF * BK * 2  , STAGE_BYTES = 8 * HTB, NXCD = 8, WGM = 8;

__host__ __device__ __forceinline__ int lds_byte(int r, int c) { const int st = (r >> 4) * 2 + (c >> 5), rr = r & 15, cc = c & 31, ob = rr * 64 + cc * 2; return st * 1024 + (ob ^ (((ob >> 9) & 1) << 5)); }
__host__ __device__ __forceinline__ void stage_rc(int b, int& R, int& C) { const int st = b / 1024, sb = b % 1024, swz = sb ^ (((sb >> 9) & 1) << 5); R = (st >> 1) * 16 + swz / 64; C = (st & 1) * 32 + (swz % 64) / 2; }
__host__ __device__ __forceinline__ int perm32(int rho) { const int n = rho >> 4, i = rho & 15; return 8 * (i >> 2) + 4 * n + (i & 3); }

struct Unit { int pm, pn, half; };
struct Gemm { const bf16_t* A; const bf16_t* Bt; int M, N, K; };

struct StaticOrder {
    int nM, nN, nwg, G, c;
    __host__ __device__ void init(int M, int N, int G_, int c_) { nM = M / BM; nN = N / BM; nwg = nM * nN; G = G_; c = c_; }
    __host__ __device__ bool next(int i, Unit& u) const {
        const long L = (long)i * G + c; if (L >= nwg) return false;
        int wgid = (int)L; { const int q = nwg / NXCD, r = nwg % NXCD, xcd = wgid % NXCD, off = wgid / NXCD; wgid = (xcd < r ? xcd * (q + 1) : r * (q + 1) + (xcd - r) * q) + off; }
        const int nig = WGM * nN, gid = wgid / nig, fm = gid * WGM, gsz = (nM - fm) < WGM ? (nM - fm) : WGM;
        u.pm = fm + ((wgid % nig) % gsz); u.pn = (wgid % nig) / gsz; u.half = 0; return true;
    }
    __device__ __forceinline__ void a_ready(const Unit&) const {}
    __device__ __forceinline__ void done(const Unit&) const {}
};

__device__ __forceinline__ unsigned cvt_pk_bf16(float lo, float hi) { unsigned r; asm volatile("v_cvt_pk_bf16_f32 %0, %1, %2" : "=v"(r) : "v"(lo), "v"(hi)); return r; }
typedef float f32x2 __attribute__((ext_vector_type(2)));
typedef unsigned u32x2 __attribute__((ext_vector_type(2)));
__device__ __forceinline__ float bf_lo(unsigned w) { return __uint_as_float(w << 16); }
__device__ __forceinline__ float bf_hi(unsigned w) { return __uint_as_float(w & 0xffff0000u); }
__device__ __forceinline__ float sigm(float x) { return __builtin_amdgcn_rcpf(1.0f + __builtin_amdgcn_exp2f(-1.4426950408889634f * x)); }
__device__ __forceinline__ u32x4 pack8(const f32x4& a, const f32x4& b) { u32x4 w; w.x = cvt_pk_bf16(a[0], a[1]); w.y = cvt_pk_bf16(a[2], a[3]); w.z = cvt_pk_bf16(b[0], b[1]); w.w = cvt_pk_bf16(b[2], b[3]); return w; }

__device__ __forceinline__ unsigned pk4_fp8(float a, float b, float c, float d) { unsigned w = __builtin_amdgcn_cvt_pk_fp8_f32(a, b, 0u, false); return __builtin_amdgcn_cvt_pk_fp8_f32(c, d, w, true); }
constexpr float W8_SCALE = 64.0f, X8_SCALE = 8.0f, A8_SCALE = 4.0f, Y8_SCALE = 32.0f;

struct EpiInProj {
    static constexpr bool PERM = true, AFTER_DRAIN = false;
    bf16_t *Qf, *Kf, *Vf, *Qd, *Kd, *Vd, *Gf, *Gd; float qscale;
    __device__ __forceinline__ void operator()(const f32x4 (&acc)[2][2][4][2], const Unit& u, int wr, int wc, int fr, int fq) const {
        const int colt = u.pn * BM, seg = colt >> 10;
        bf16_t* base; int ldc, col, rowoff = 0; float sc = 1.f; bool sg = false;
        const int kvoff = 64 * ((u.pm >> 3) + 1);
        if (seg < 6) { ldc = 1024; col = colt & 1023;
            if (seg == 0) { base = Qf; sc = qscale; } else if (seg == 1) { base = Kf; rowoff = kvoff; } else if (seg == 2) { base = Vf; rowoff = kvoff; }
            else if (seg == 3) { base = Qd; sc = qscale; } else if (seg == 4) { base = Kd; rowoff = kvoff; } else { base = Vd; rowoff = kvoff; } }
        else { ldc = 2048; sg = true; if (seg < 8) { base = Gf; col = colt - 6144; } else { base = Gd; col = colt - 8192; } }
        const int row0 = u.pm * BM + rowoff + wr * 64 + fr, col0 = col + wc * 32 + 8 * fq;
#pragma unroll
        for (int ai = 0; ai < 2; ++ai)
#pragma unroll
            for (int m = 0; m < 4; ++m) { bf16_t* rowp = base + (size_t)(row0 + ai * HALF + m * 16) * ldc + col0;
#pragma unroll
                for (int bj = 0; bj < 2; ++bj) { f32x4 v0 = acc[ai][bj][m][0], v1 = acc[ai][bj][m][1];
                    if (sg) {
#pragma unroll
                        for (int j = 0; j < 4; ++j) { v0[j] = sigm(v0[j]); v1[j] = sigm(v1[j]); } }
                    else { v0 = v0 * sc; v1 = v1 * sc; }
                    *(u32x4*)(rowp + bj * HALF) = pack8(v0, v1); } }
    }
};
struct EpiGate2 {
    static constexpr bool PERM = true, AFTER_DRAIN = false;
    const bf16_t* Gf; const bf16_t* Gd; bf16_t* T1; bf16_t* O;
    __device__ __forceinline__ void operator()(const f32x4 (&acc)[2][2][4][2], const Unit& u, int wr, int wc, int fr, int fq) const {
        const bool second = u.pm >= 32; const int pm = second ? u.pm - 32 : u.pm, pn = second ? u.pn - 8 : u.pn;
        const bf16_t* G = second ? Gd : Gf; bf16_t* out = second ? O : T1;
        const int row0 = pm * BM + wr * 64 + fr, col0 = pn * BM + wc * 32 + 8 * fq;
#pragma unroll
        for (int ai = 0; ai < 2; ++ai)
#pragma unroll
            for (int m = 0; m < 4; ++m) { const size_t off = (size_t)(row0 + ai * HALF + m * 16) * 2048 + col0;
#pragma unroll
                for (int bj = 0; bj < 2; ++bj) { f32x4 v0 = acc[ai][bj][m][0], v1 = acc[ai][bj][m][1];
                    const u32x4 g = *(const u32x4*)(G + off + bj * HALF);
                    v0[0] *= bf_lo(g.x); v0[1] *= bf_hi(g.x); v0[2] *= bf_lo(g.y); v0[3] *= bf_hi(g.y); v1[0] *= bf_lo(g.z); v1[1] *= bf_hi(g.z); v1[2] *= bf_lo(g.w); v1[3] *= bf_hi(g.w);
                    if (second) { const u32x4 t = *(const u32x4*)(T1 + off + bj * HALF);
                        v0[0] += bf_lo(t.x); v0[1] += bf_hi(t.x); v0[2] += bf_lo(t.y); v0[3] += bf_hi(t.y); v1[0] += bf_lo(t.z); v1[1] += bf_hi(t.z); v1[2] += bf_lo(t.w); v1[3] += bf_hi(t.w); }
                    *(u32x4*)(out + off + bj * HALF) = pack8(v0, v1); } }
    }
};
struct PairOrder {
    StaticOrder S;
    __device__ __forceinline__ bool next(int i, Unit& u) const { if (!S.next(i >> 1, u)) return false; if (i & 1) { u.pm += 32; u.pn += 8; } return true; }
    __device__ __forceinline__ void a_ready(const Unit&) const {}
    __device__ __forceinline__ void done(const Unit&) const {}
};
struct EpiResF32 {
    static constexpr bool PERM = false, AFTER_DRAIN = false;
    const float* X; float* C;
    __device__ __forceinline__ void operator()(const f32x4 (&acc)[2][2][4][2], const Unit& u, int wr, int wc, int fr, int fq) const {
        const int row0 = u.pm * BM + wr * 64 + fr, col0 = u.pn * BM + wc * 32 + 4 * fq;
#pragma unroll
        for (int ai = 0; ai < 2; ++ai)
#pragma unroll
            for (int m = 0; m < 4; ++m) { const size_t off = (size_t)(row0 + ai * HALF + m * 16) * 2048 + col0;
#pragma unroll
                for (int bj = 0; bj < 2; ++bj)
#pragma unroll
                    for (int n = 0; n < 2; ++n) { const f32x4 xv = *(const f32x4*)(X + off + bj * HALF + n * 16); *(f32x4*)(C + off + bj * HALF + n * 16) = acc[ai][bj][m][n] + xv; } }
    }
};
struct EpiSwiglu {
    static constexpr bool PERM = true, AFTER_DRAIN = false;
    const float* bgu; unsigned char* ACT;
    __device__ __forceinline__ void operator()(const f32x4 (&acc)[2][2][4][2], const Unit& u, int wr, int wc, int fr, int fq) const {
        const int e = u.pn >> 4, j = u.pn & 15;
        const int row0 = u.pm * HALF + wr * 64 + fr, cl = j * HALF + wc * 32 + 8 * fq;
        const float* bg = bgu + (size_t)e * 4096 + cl;
        const f32x4 bg0 = *(const f32x4*)(bg), bg1 = *(const f32x4*)(bg + 4), bl0 = *(const f32x4*)(bg + 2048), bl1 = *(const f32x4*)(bg + 2048 + 4);
        const float isc = 1.0f / (W8_SCALE * X8_SCALE);
#pragma unroll
        for (int ai = 0; ai < 2; ++ai) { if (ai == 1 && u.half) break;
#pragma unroll
            for (int m = 0; m < 4; ++m) {
                f32x4 g0 = acc[ai][0][m][0] * isc + bg0, g1 = acc[ai][0][m][1] * isc + bg1, l0 = acc[ai][1][m][0] * isc + bl0, l1 = acc[ai][1][m][1] * isc + bl1, a0, a1;
#pragma unroll
                for (int i = 0; i < 4; ++i) {
                    float xg = fminf(g0[i], 7.0f), xl = fminf(fmaxf(l0[i], -7.0f), 7.0f); a0[i] = xg * sigm(1.702f * xg) * (xl + 1.0f) * A8_SCALE;
                    xg = fminf(g1[i], 7.0f); xl = fminf(fmaxf(l1[i], -7.0f), 7.0f); a1[i] = xg * sigm(1.702f * xg) * (xl + 1.0f) * A8_SCALE; }
                u32x2 w; w.x = pk4_fp8(a0[0], a0[1], a0[2], a0[3]); w.y = pk4_fp8(a1[0], a1[1], a1[2], a1[3]);
                *(u32x2*)(ACT + (size_t)(row0 + ai * HALF + m * 16) * 2048 + cl) = w; } }
    }
};
struct EpiDown {
    static constexpr bool PERM = true, AFTER_DRAIN = false;
    const float* bd; unsigned char* YS;
    __device__ __forceinline__ void operator()(const f32x4 (&acc)[2][2][4][2], const Unit& u, int wr, int wc, int fr, int fq) const {
        const int j = u.pn & 7;
        const int row0 = u.pm * HALF + wr * 64 + fr, col0 = j * BM + wc * 32 + 8 * fq;
        const float* bp = bd + (size_t)u.pn * BM + wc * 32 + 8 * fq;
        const float isc = 1.0f / (W8_SCALE * A8_SCALE);
        f32x4 bv[2][2];
#pragma unroll
        for (int bj = 0; bj < 2; ++bj)
#pragma unroll
            for (int n = 0; n < 2; ++n) bv[bj][n] = *(const f32x4*)(bp + bj * HALF + 4 * n);
#pragma unroll
        for (int ai = 0; ai < 2; ++ai) { if (ai == 1 && u.half) break;
#pragma unroll
            for (int m = 0; m < 4; ++m) { unsigned char* rowp = YS + (size_t)(row0 + ai * HALF + m * 16) * 2048 + col0;
#pragma unroll
                for (int bj = 0; bj < 2; ++bj) { const f32x4 y0 = (acc[ai][bj][m][0] * isc + bv[bj][0]) * Y8_SCALE, y1 = (acc[ai][bj][m][1] * isc + bv[bj][1]) * Y8_SCALE;
                    u32x2 w; w.x = pk4_fp8(y0[0], y0[1], y0[2], y0[3]); w.y = pk4_fp8(y1[0], y1[1], y1[2], y1[3]); *(u32x2*)(rowp + bj * HALF) = w; } } }
    }
};
struct ListOrder {
    const PG8_LAS int* list; int n; const PG8_LAS int* tokl;
    __device__ __forceinline__ bool next(int i, Unit& u) const { if (i >= n) return false; u.pm = __builtin_amdgcn_readfirstlane(list[2 * i]); const int w = __builtin_amdgcn_readfirstlane(list[2 * i + 1]); u.pn = w & 0xffff; u.half = w >> 16; return true; }
    __device__ __forceinline__ void a_ready(const Unit&) const {}
    __device__ __forceinline__ void done(const Unit&) const {}
};
struct BgW { const float* w_gu; const float* w_dn; unsigned char* wgu8; unsigned char* wd8; int pos, end, G, pend; float scale; int split, skip; };
constexpr int BGW_GU = 32 * 1024, BGW_ALL = BGW_GU + 32 * 512;
__device__ __forceinline__ void bgw_glds16(const void* gsrc, unsigned lds_dst) { unsigned keep;
    asm volatile("s_mov_b32 %0, m0\n\ts_mov_b32 m0, %2\n\ts_nop 0\n\tglobal_load_lds_dwordx4 %1, off\n\ts_mov_b32 m0, %0" : "=&s"(keep) : "v"(gsrc), "s"(lds_dst) : "memory"); }
__device__ __forceinline__ void bgw_glds16s(const float* sbase, unsigned voff, unsigned lds_dst) { unsigned keep;
    asm volatile("s_mov_b32 %0, m0\n\ts_mov_b32 m0, %3\n\ts_nop 0\n\tglobal_load_lds_dwordx4 %1, %2\n\ts_mov_b32 m0, %0" : "=&s"(keep) : "v"(voff), "s"(sbase), "s"(lds_dst) : "memory"); }
__device__ __forceinline__ void bgw_addr(const BgW& b, int j_, int wid, const float*& src, unsigned char*& dst, int& ldw) {
    const int idx = j_ < b.split ? j_ : j_ + b.skip;
    if (idx < BGW_GU) { const int e = idx >> 10, r = idx & 1023, n64 = r & 63, kb = r >> 6, nb = 64 * n64 + 8 * wid;
        const int drow = nb < 2048 ? 256 * (nb >> 7) + (nb & 127) : 256 * ((nb - 2048) >> 7) + 128 + (nb & 127);
        ldw = 4096; src = b.w_gu + (size_t)e * 2048 * 4096 + (size_t)(128 * kb) * 4096 + nb; dst = b.wgu8 + (size_t)e * 4096 * 2048 + (size_t)drow * 2048 + 128 * kb; }
    else { const int j = idx - BGW_GU, e = j >> 9, r = j & 511, n64 = r & 31, kb = r >> 5, nb = 64 * n64 + 8 * wid;
        ldw = 2048; src = b.w_dn + (size_t)e * 2048 * 2048 + (size_t)(128 * kb) * 2048 + nb; dst = b.wd8 + (size_t)e * 2048 * 2048 + (size_t)nb * 2048 + 128 * kb; }
}
__device__ __forceinline__ void bgw_issue2(const BgW& b, int idx, unsigned slot, int wid, int lane, int h) {
    asm volatile("" : "+v"(lane));
    const float* src; unsigned char* dst; int ldw; bgw_addr(b, idx, wid, src, dst, ldw);
    const unsigned rl = (unsigned)(lane >> 1);
#pragma unroll
    for (int p = 0; p < 2; ++p) { const int pc = 2 * h + p; const unsigned kl = rl ^ ((rl >> 4) & 1u) ^ (2u * (unsigned)(pc & 1));
        bgw_glds16s(src + (size_t)(32 * pc) * ldw, (kl * (unsigned)ldw + 4u * (unsigned)(lane & 1)) * 4u, (unsigned)__builtin_amdgcn_readfirstlane(slot + pc * 1024)); }
}
__device__ __forceinline__ void bgw_cload(float (&v)[16], const PG8_LAS float* sl, int lane) {
    const int kq = lane >> 3, x = (kq & 1) ^ (2 * ((kq >> 1) & 1));
    const PG8_LAS float* p = sl + (kq >> 1) * 256 + (16 * (kq & 1)) * 8 + (lane & 7);
    const PG8_LAS float* p0 = p + (0 ^ x) * 8; const PG8_LAS float* p1 = p + (1 ^ x) * 8; const PG8_LAS float* p2 = p + (2 ^ x) * 8; const PG8_LAS float* p3 = p + (3 ^ x) * 8;
#pragma unroll
    for (int q = 0; q < 4; ++q) { v[4 * q + 0] = p0[32 * q]; v[4 * q + 1] = p1[32 * q]; v[4 * q + 2] = p2[32 * q]; v[4 * q + 3] = p3[32 * q]; }
}
__device__ __forceinline__ void bgw_cstore(const BgW& b, int idx, const float (&v)[16], int wid, int lane) {
    const float* src; unsigned char* dst; int ldw; bgw_addr(b, idx, wid, src, dst, ldw);
    const int n = lane & 7, kq = lane >> 3; const float sc = b.scale; u32x4 o;
    o.x = __builtin_amdgcn_cvt_pk_fp8_f32(v[2] * sc, v[3] * sc, __builtin_amdgcn_cvt_pk_fp8_f32(v[0] * sc, v[1] * sc, 0u, false), true);
    o.y = __builtin_amdgcn_cvt_pk_fp8_f32(v[6] * sc, v[7] * sc, __builtin_amdgcn_cvt_pk_fp8_f32(v[4] * sc, v[5] * sc, 0u, false), true);
    o.z = __builtin_amdgcn_cvt_pk_fp8_f32(v[10] * sc, v[11] * sc, __builtin_amdgcn_cvt_pk_fp8_f32(v[8] * sc, v[9] * sc, 0u, false), true);
    o.w = __builtin_amdgcn_cvt_pk_fp8_f32(v[14] * sc, v[15] * sc, __builtin_amdgcn_cvt_pk_fp8_f32(v[12] * sc, v[13] * sc, 0u, false), true);
    *(u32x4*)(dst + (size_t)n * 2048 + 16 * kq) = o;
}
__device__ __forceinline__ void bgw_st16(const BgW& b, int idx, u32x4 o, int wid, int lane) { const float* src; unsigned char* dst; int ldw; bgw_addr(b, idx, wid, src, dst, ldw); const unsigned off = (unsigned)(lane & 7) * 2048u + 16u * (unsigned)(lane >> 3); *(__attribute__((address_space(1))) u32x4*)((__attribute__((address_space(1))) unsigned char*)dst + off) = o; }
__device__ __forceinline__ void bgw_consume(const BgW& b, int idx, const PG8_LAS float* sl, int wid, int lane) {
    asm volatile("" : "+v"(lane));
    const int kq = lane >> 3, x = (kq & 1) ^ (2 * ((kq >> 1) & 1)); const float sc = b.scale;
    const PG8_LAS float* p = sl + (kq >> 1) * 256 + (16 * (kq & 1)) * 8 + (lane & 7);
    const PG8_LAS float* p0 = p + (0 ^ x) * 8; const PG8_LAS float* p1 = p + (1 ^ x) * 8; const PG8_LAS float* p2 = p + (2 ^ x) * 8; const PG8_LAS float* p3 = p + (3 ^ x) * 8;
    u32x4 o;
    { const float a0 = p0[0], a1 = p1[0], a2 = p2[0], a3 = p3[0], a4 = p0[32], a5 = p1[32], a6 = p2[32], a7 = p3[32];
      o.x = __builtin_amdgcn_cvt_pk_fp8_f32(a2 * sc, a3 * sc, __builtin_amdgcn_cvt_pk_fp8_f32(a0 * sc, a1 * sc, 0u, false), true);
      o.y = __builtin_amdgcn_cvt_pk_fp8_f32(a6 * sc, a7 * sc, __builtin_amdgcn_cvt_pk_fp8_f32(a4 * sc, a5 * sc, 0u, false), true); }
    asm volatile("" ::: "memory");
    { const float a0 = p0[64], a1 = p1[64], a2 = p2[64], a3 = p3[64], a4 = p0[96], a5 = p1[96], a6 = p2[96], a7 = p3[96];
      o.z = __builtin_amdgcn_cvt_pk_fp8_f32(a2 * sc, a3 * sc, __builtin_amdgcn_cvt_pk_fp8_f32(a0 * sc, a1 * sc, 0u, false), true);
      o.w = __builtin_amdgcn_cvt_pk_fp8_f32(a6 * sc, a7 * sc, __builtin_amdgcn_cvt_pk_fp8_f32(a4 * sc, a5 * sc, 0u, false), true); }
    bgw_st16(b, idx, o, wid, lane);
}
__device__ __forceinline__ f32x4 bgw_rd4(const PG8_LAS float* sl, int lane, int q) { const PG8_LAS float* p = sl + (16 * (lane >> 3) + 4 * q) * 8 + (lane & 7); f32x4 v; v.x = p[0]; v.y = p[8]; v.z = p[16]; v.w = p[24]; return v; }
__device__ __forceinline__ unsigned bgw_cvt4(f32x4 v, float sc) { return __builtin_amdgcn_cvt_pk_fp8_f32(v.z * sc, v.w * sc, __builtin_amdgcn_cvt_pk_fp8_f32(v.x * sc, v.y * sc, 0u, false), true); }
template <class Epi, class Sched, bool ALIGN_EPI = false, bool SP2 = false, bool F8 = false, int BGPM = -1, bool GATHER = false>
__device__ __forceinline__ void gemm_phase(PG8_LAS unsigned char* lds, const Gemm g, const Sched& S, const Epi& E, BgW* bg = nullptr) {
    constexpr bool BGON = BGPM >= 0;
    int tid_o = threadIdx.x; asm volatile("" : "+v"(tid_o));
    const int tid = tid_o, wid = __builtin_amdgcn_readfirstlane(tid >> 6), lane = tid & 63, wr = wid >> 2, wc = wid & 3, fr = lane & 15, fq = lane >> 4;
    const int K = g.K, nt = K / BK;
    unsigned voffA[2], voffB[2]; int gR[2]; unsigned gC[2];
#pragma unroll
    for (int i = 0; i < 2; ++i) { int R, C; stage_rc(tid * 16 + i * 8192, R, C); const int Rb = Epi::PERM ? ((R & ~31) + perm32(R & 31)) : R;
        voffA[i] = (unsigned)(R * K + C) * 2u; voffB[i] = (unsigned)(Rb * K + C) * 2u; gR[i] = R; gC[i] = (unsigned)C * 2u; }
    unsigned gc00 = 0, gc01 = 0, gc10 = 0, gc11 = 0, gn00 = 0, gn01 = 0, gn10 = 0, gn11 = 0;
    static_assert(!GATHER || SP2, "gather: SP2 schedule only");
    const size_t kstep = (size_t)(BK * 2);
    const size_t hstep = (size_t)HALF * K * 2;
    const size_t tstep = 2 * hstep;
    const size_t astep = F8 ? hstep : tstep;
    const unsigned ldsw = (unsigned)wid * 1024u;
    const int aoff = lds_byte(wr * 64 + fr, fq * 8), boff = lds_byte(wc * 32 + fr, fq * 8);
#define PG8_SA(b, h) (((b) * 2 + (h)) * HTB)
#define PG8_SB(b, h) ((4 + (b) * 2 + (h)) * HTB)
#define PG8_STAGE(bufoff, gbase, voff) do { _Pragma("unroll") for (int _i = 0; _i < 2; ++_i) \
        __builtin_amdgcn_global_load_lds((const unsigned*)((const char*)(gbase) + (voff)[_i]), (PG8_LAS unsigned*)(lds + (bufoff) + ldsw + _i * 8192), 16, 0, 0); } while (0)
#define PG8_STAGE_A(bufoff, gbase, h, NX) do { if constexpr (GATHER) { unsigned go_[2]; \
            if ((h) == 0) { go_[0] = ((NX) && last_) ? gn00 : gc00; go_[1] = ((NX) && last_) ? gn01 : gc01; } else { go_[0] = ((NX) && last_) ? gn10 : gc10; go_[1] = ((NX) && last_) ? gn11 : gc11; } \
            PG8_STAGE(bufoff, gbase, go_); } \
        else PG8_STAGE(bufoff, (const char*)(gbase) + (h) * hstep, voffA); } while (0)
#define PG8_LDA(dst, b, h) do { _Pragma("unroll") for (int m = 0; m < 4; ++m) _Pragma("unroll") for (int k = 0; k < 2; ++k) dst[m][k] = *(const PG8_LAS bf16x8*)(lds + PG8_SA(b, h) + aoff + m * 2048 + k * 1024); } while (0)
#define PG8_LDB(dst, b, h) do { _Pragma("unroll") for (int n = 0; n < 2; ++n) _Pragma("unroll") for (int k = 0; k < 2; ++k) dst[n][k] = *(const PG8_LAS bf16x8*)(lds + PG8_SB(b, h) + boff + n * 2048 + k * 1024); } while (0)
#define PG8_MMA(ai, bj, At, Bt) do { __builtin_amdgcn_s_setprio(1); \
        if constexpr (F8) { _Pragma("unroll") for (int m = 0; m < 4; ++m) _Pragma("unroll") for (int n = 0; n < 2; ++n) { \
            const v8i32 fa_ = __builtin_shufflevector(__builtin_bit_cast(v4i32, At[m][0]), __builtin_bit_cast(v4i32, At[m][1]), 0, 1, 2, 3, 4, 5, 6, 7); \
            const v8i32 fb_ = __builtin_shufflevector(__builtin_bit_cast(v4i32, Bt[n][0]), __builtin_bit_cast(v4i32, Bt[n][1]), 0, 1, 2, 3, 4, 5, 6, 7); \
            asm volatile("v_mfma_f32_16x16x128_f8f6f4 %0, %1, %2, %0" : "+v"(acc[ai][bj][m][n]) : "v"(fb_), "v"(fa_)); } } \
        else { _Pragma("unroll") for (int m = 0; m < 4; ++m) _Pragma("unroll") for (int n = 0; n < 2; ++n) _Pragma("unroll") for (int k = 0; k < 2; ++k) \
            acc[ai][bj][m][n] = __builtin_amdgcn_mfma_f32_16x16x32_bf16(Bt[n][k], At[m][k], acc[ai][bj][m][n], 0, 0, 0); } \
        __builtin_amdgcn_s_setprio(0); } while (0)
#define PG8_MMA_M(ai, bj, At, Bt, m0, m1) do { __builtin_amdgcn_s_setprio(1); \
        if constexpr (F8) { _Pragma("unroll") for (int m = m0; m < m1; ++m) _Pragma("unroll") for (int n = 0; n < 2; ++n) { \
            const v8i32 fa_ = __builtin_shufflevector(__builtin_bit_cast(v4i32, At[m][0]), __builtin_bit_cast(v4i32, At[m][1]), 0, 1, 2, 3, 4, 5, 6, 7); \
            const v8i32 fb_ = __builtin_shufflevector(__builtin_bit_cast(v4i32, Bt[n][0]), __builtin_bit_cast(v4i32, Bt[n][1]), 0, 1, 2, 3, 4, 5, 6, 7); \
            asm volatile("v_mfma_f32_16x16x128_f8f6f4 %0, %1, %2, %0" : "+v"(acc[ai][bj][m][n]) : "v"(fb_), "v"(fa_)); } } \
        else { _Pragma("unroll") for (int m = m0; m < m1; ++m) _Pragma("unroll") for (int n = 0; n < 2; ++n) _Pragma("unroll") for (int k = 0; k < 2; ++k) \
            acc[ai][bj][m][n] = __builtin_amdgcn_mfma_f32_16x16x32_bf16(Bt[n][k], At[m][k], acc[ai][bj][m][n], 0, 0, 0); } \
        __builtin_amdgcn_s_setprio(0); } while (0)
#define PG8_WAIT_V(n) asm volatile("s_waitcnt vmcnt(" #n ")" ::: "memory")
#define PG8_WAIT_L(n) asm volatile("s_waitcnt lgkmcnt(" #n ")" ::: "memory")
#define PG8_BAR __builtin_amdgcn_s_barrier()
#define PG8_SCHED __builtin_amdgcn_sched_barrier(0)
    int nbg = 0;
#define PG8_WAIT_V8N() do { if constexpr (BGON) { if (nbg == 5) PG8_WAIT_V(13); else if (nbg == 4) PG8_WAIT_V(12); else if (nbg == 1) PG8_WAIT_V(9); else PG8_WAIT_V(8); } else PG8_WAIT_V(8); } while (0)
    const unsigned bg_slot = (unsigned)(size_t)(lds + 131072 + wid * 4096); const PG8_LAS float* bg_sl = (const PG8_LAS float*)(lds + 131072 + wid * 4096);
#define PG8_MMA_BG(At, B0, B1) do { const bool iss_ = bg->pos < bg->end; const bool mm_ = !F8 || !cur.half; \
        if (mm_) { PG8_MMA(1, 0, At, B0); PG8_MMA_M(1, 1, At, B1, 0, 2); } \
        if (iss_) { asm volatile("s_waitcnt lgkmcnt(0)" ::: "memory"); bgw_issue2(*bg, bg->pos, bg_slot, wid, lane, 0); } \
        if (mm_) PG8_MMA_M(1, 1, At, B1, 2, 3); \
        if (iss_) { bgw_issue2(*bg, bg->pos, bg_slot, wid, lane, 1); bg->pend = bg->pos; bg->pos += bg->G; nbg += 4; } else bg->pend = -1; \
        if (mm_) PG8_MMA_M(1, 1, At, B1, 3, 4); } while (0)
    Unit cur, nxt; int ui = 0;
    if (!S.next(0, cur)) return;
    f32x4 acc[2][2][4][2];
#pragma unroll
    for (int a = 0; a < 2; ++a)
#pragma unroll
        for (int b = 0; b < 2; ++b)
#pragma unroll
            for (int m = 0; m < 4; ++m)
#pragma unroll
                for (int n = 0; n < 2; ++n) acc[a][b][m][n] = (f32x4){0.f, 0.f, 0.f, 0.f};
    bf16x8 At[4][2], B0[2][2], B1[2][2];
    const char* cA = GATHER ? (const char*)g.A : (const char*)g.A + (size_t)cur.pm * astep; const char* cB = (const char*)g.Bt + (size_t)cur.pn * tstep;
    if constexpr (GATHER) { const PG8_LAS int* tk = S.tokl; gc00 = (unsigned)tk[gR[0]] + gC[0]; gc01 = (unsigned)tk[gR[1]] + gC[1]; gc10 = (unsigned)tk[128 + gR[0]] + gC[0]; gc11 = (unsigned)tk[128 + gR[1]] + gC[1]; }
    bool last_ = false;
    S.a_ready(cur);
    if constexpr (SP2) {
        PG8_STAGE(PG8_SB(0, 0), cB, voffB); PG8_STAGE(PG8_SB(0, 1), cB + hstep, voffB); PG8_STAGE_A(PG8_SA(0, 0), cA, 0, false); PG8_STAGE_A(PG8_SA(0, 1), cA, 1, false);
        if (wr == 1) PG8_BAR;
        PG8_WAIT_V(2); PG8_BAR;
        PG8_STAGE(PG8_SB(1, 0), cB + kstep, voffB); PG8_STAGE_A(PG8_SA(1, 0), cA + kstep, 0, false); PG8_STAGE(PG8_SB(1, 1), cB + hstep + kstep, voffB);
        PG8_WAIT_V(6); PG8_BAR;
    } else {
        PG8_STAGE(PG8_SB(0, 0), cB, voffB); PG8_STAGE(PG8_SA(0, 0), cA, voffA); PG8_STAGE(PG8_SB(0, 1), cB + hstep, voffB); PG8_STAGE(PG8_SA(0, 1), cA + hstep, voffA);
        if (wr == 1) PG8_BAR;
        PG8_WAIT_V(4); PG8_BAR;
        PG8_STAGE(PG8_SB(1, 0), cB + kstep, voffB); PG8_STAGE(PG8_SA(1, 0), cA + kstep, voffA); PG8_STAGE(PG8_SB(1, 1), cB + hstep + kstep, voffB);
        PG8_WAIT_V(6); PG8_BAR;
    }
    for (;;) {
        const bool has_next = S.next(ui + 1, nxt);
        const char* nA = (GATHER || !has_next) ? cA : (const char*)g.A + (size_t)nxt.pm * astep; const char* nB = has_next ? (const char*)g.Bt + (size_t)nxt.pn * tstep : cB;
        if constexpr (GATHER) { if (has_next) { const PG8_LAS int* tk = S.tokl + 256 * (ui + 1); gn00 = (unsigned)tk[gR[0]] + gC[0]; gn01 = (unsigned)tk[gR[1]] + gC[1]; gn10 = (unsigned)tk[128 + gR[0]] + gC[0]; gn11 = (unsigned)tk[128 + gR[1]] + gC[1]; }
            else { gn00 = gc00; gn01 = gc01; gn10 = gc10; gn11 = gc11; } }
        for (int t = 0; t < nt; t += 2) {
            const bool last = (t == nt - 2); last_ = last;
            const char* a1 = cA + (size_t)(t + 1) * kstep;
            const char* a2 = last ? nA : cA + (size_t)(t + 2) * kstep; const char* b2 = last ? nB : cB + (size_t)(t + 2) * kstep;
            const char* a3 = a2 + kstep; const char* b3 = b2 + kstep;
            if (last && has_next) S.a_ready(nxt);
            if constexpr (SP2) {
            PG8_LDB(B0, 0, 0); PG8_LDB(B1, 0, 1); PG8_SCHED; PG8_LDA(At, 0, 0); PG8_STAGE_A(PG8_SA(1, 1), a1, 1, false);
            PG8_WAIT_V8N(); PG8_WAIT_L(0); PG8_BAR; PG8_MMA(0, 0, At, B0); PG8_MMA(0, 1, At, B1); PG8_BAR; PG8_SCHED;
            PG8_LDA(At, 0, 1); PG8_STAGE(PG8_SB(0, 0), b2, voffB); PG8_STAGE(PG8_SB(0, 1), b2 + hstep, voffB); PG8_STAGE_A(PG8_SA(0, 0), a2, 0, true);
            PG8_WAIT_V8N(); nbg = 0;
            PG8_WAIT_L(0); PG8_BAR; if (!F8 || !cur.half) { PG8_MMA(1, 0, At, B0); PG8_MMA(1, 1, At, B1); } PG8_BAR; PG8_SCHED;
            PG8_LDB(B0, 1, 0); PG8_LDB(B1, 1, 1); PG8_SCHED; PG8_LDA(At, 1, 0); PG8_STAGE_A(PG8_SA(0, 1), a2, 1, true);
            PG8_WAIT_V(8); PG8_WAIT_L(0); PG8_BAR; PG8_MMA(0, 0, At, B0); PG8_MMA(0, 1, At, B1); PG8_BAR; PG8_SCHED;
            PG8_LDA(At, 1, 1); PG8_STAGE(PG8_SB(1, 0), b3, voffB); PG8_STAGE(PG8_SB(1, 1), b3 + hstep, voffB); PG8_STAGE_A(PG8_SA(1, 0), a3, 0, true);
            PG8_WAIT_V(8); PG8_WAIT_L(0);
            if constexpr (BGON) { if ((t & BGPM) == 0 && bg->pend >= 0) { bgw_consume(*bg, bg->pend, bg_sl, wid, lane); nbg = 1; } }
            PG8_BAR;
            if constexpr (BGON) { if ((t & BGPM) == 0) PG8_MMA_BG(At, B0, B1); else if (!F8 || !cur.half) { PG8_MMA(1, 0, At, B0); PG8_MMA(1, 1, At, B1); } }
            else { if (!F8 || !cur.half) { PG8_MMA(1, 0, At, B0); PG8_MMA(1, 1, At, B1); } }
            PG8_BAR; PG8_SCHED;
            } else {
            PG8_LDB(B0, 0, 0); PG8_SCHED; PG8_LDA(At, 0, 0); PG8_STAGE(PG8_SA(1, 1), a1 + hstep, voffA);
            PG8_WAIT_L(8); PG8_BAR; PG8_WAIT_L(0); PG8_MMA(0, 0, At, B0); PG8_BAR; PG8_SCHED;
            PG8_LDB(B1, 0, 1); PG8_STAGE(PG8_SB(0, 0), b2, voffB);
            PG8_BAR; PG8_WAIT_L(0); PG8_MMA(0, 1, At, B1); PG8_BAR;
            PG8_LDA(At, 0, 1); PG8_STAGE(PG8_SA(0, 0), a2, voffA);
            PG8_BAR; PG8_WAIT_L(0); PG8_MMA(1, 0, At, B0); PG8_BAR; PG8_SCHED;
            PG8_STAGE(PG8_SB(0, 1), b2 + hstep, voffB);
            PG8_WAIT_V(6); PG8_BAR; PG8_MMA(1, 1, At, B1); PG8_BAR;
            PG8_LDB(B0, 1, 0); PG8_SCHED; PG8_LDA(At, 1, 0); PG8_STAGE(PG8_SA(0, 1), a2 + hstep, voffA);
            PG8_WAIT_L(8); PG8_BAR; PG8_WAIT_L(0); PG8_MMA(0, 0, At, B0); PG8_BAR; PG8_SCHED;
            PG8_LDB(B1, 1, 1); PG8_STAGE(PG8_SB(1, 0), b3, voffB);
            PG8_BAR; PG8_WAIT_L(0); PG8_MMA(0, 1, At, B1); PG8_BAR;
            PG8_LDA(At, 1, 1); PG8_STAGE(PG8_SA(1, 0), a3, voffA);
            PG8_BAR; PG8_WAIT_L(0); PG8_MMA(1, 0, At, B0); PG8_BAR; PG8_SCHED;
            PG8_STAGE(PG8_SB(1, 1), b3 + hstep, voffB);
            PG8_WAIT_V(6); PG8_BAR; PG8_MMA(1, 1, At, B1); PG8_BAR;
            }
        }
        if constexpr (ALIGN_EPI) { if (wr == 0) PG8_BAR; }
        if constexpr (F8) asm volatile("s_nop 15\n\ts_nop 7" ::: "memory");
        if constexpr (!Epi::AFTER_DRAIN) { E(acc, cur, wr, wc, fr, fq); S.done(cur); }
        if (!has_next) break;
#pragma unroll
        for (int a = 0; a < 2; ++a)
#pragma unroll
            for (int b = 0; b < 2; ++b)
#pragma unroll
                for (int m = 0; m < 4; ++m)
#pragma unroll
                    for (int n = 0; n < 2; ++n) acc[a][b][m][n] = (f32x4){0.f, 0.f, 0.f, 0.f};
        cur = nxt; cA = nA; cB = nB; ++ui;
        if constexpr (GATHER) { gc00 = gn00; gc01 = gn01; gc10 = gn10; gc11 = gn11; }
        if constexpr (ALIGN_EPI) { if (wr == 1) PG8_BAR; }
    }
    PG8_WAIT_V(0);
    if constexpr (!ALIGN_EPI) { if (wr == 0) PG8_BAR; }
    PG8_BAR;
    if constexpr (Epi::AFTER_DRAIN) { E.fused(acc, cur, wr, wc, fr, fq, lds, wid, lane); S.done(cur); }
    if constexpr (BGON) {
        if (bg->pend >= 0) bgw_consume(*bg, bg->pend, bg_sl, wid, lane);
        while (bg->pos < bg->end) { asm volatile("s_waitcnt lgkmcnt(0)" ::: "memory"); bgw_issue2(*bg, bg->pos, bg_slot, wid, lane, 0); bgw_issue2(*bg, bg->pos, bg_slot, wid, lane, 1); asm volatile("s_waitcnt vmcnt(0)" ::: "memory"); bgw_consume(*bg, bg->pos, bg_sl, wid, lane); bg->pos += bg->G; }
        bg->pend = -1; asm volatile("s_waitcnt lgkmcnt(0)" ::: "memory"); }
#undef PG8_MMA_BG
#undef PG8_WAIT_V8N
#undef PG8_MMA_M
#undef PG8_SA
#undef PG8_SB
#undef PG8_STAGE
#undef PG8_STAGE_A
#undef PG8_LDA
#undef PG8_LDB
#undef PG8_MMA
#undef PG8_WAIT_V
#undef PG8_WAIT_L
#undef PG8_BAR
#undef PG8_SCHED
}
}
namespace att {
#define ATT_LAS __attribute__((address_space(3)))
typedef unsigned short bf16_t;
typedef short bf16x8 __attribute__((ext_vector_type(8)));
typedef short s16x4 __attribute__((ext_vector_type(4)));
typedef float f32x16 __attribute__((ext_vector_type(16)));
typedef float f32x4 __attribute__((ext_vector_type(4)));
constexpr int KV_PER_B = 2112, NQ_PER_B = 2048, PITCH = 1024;
constexpr int L_K = 0, L_V = 32768, L_NB = 65536, L_WSF = L_NB + 512, L_TAB = L_WSF + 2048, L_Q = L_TAB + 512, ATT_LDS = L_Q + 64;
constexpr float THR = 8.0f;
constexpr int L_BG = 69632, BG_SLOT = 8192, BG_E0 = 4, BG_PER_E = 512;
struct Bg { const float* w; unsigned char* w8; int pos, end; float scale; };
__device__ __forceinline__ void glds16(const void* gsrc, unsigned lds_dst) { unsigned keep;
    asm volatile("s_mov_b32 %0, m0\n\ts_mov_b32 m0, %2\n\ts_nop 0\n\tglobal_load_lds_dwordx4 %1, off\n\ts_mov_b32 m0, %0" : "=&s"(keep) : "v"(gsrc), "s"(lds_dst) : "memory"); }
__device__ __forceinline__ void bg_issue(const Bg& g, ATT_LAS char* lds, int wid, int lane) {
    const int idx = g.pos, e = BG_E0 + idx / BG_PER_E, r = idx % BG_PER_E, nsl = r >> 4, kb = r & 15;
    const float* src = g.w + (size_t)e * 2048 * 4096 + (size_t)(128 * kb + (lane >> 2)) * 4096 + 128 * nsl + 16 * wid + 4 * (lane & 3);
    const unsigned slot = (unsigned)(size_t)(lds + L_BG + wid * BG_SLOT);
#pragma unroll
    for (int i = 0; i < 8; ++i) glds16(src + (size_t)(16 * i) * 4096, (unsigned)__builtin_amdgcn_readfirstlane(slot + i * 1024));
}
__device__ __forceinline__ void bg_consume(const Bg& g, ATT_LAS char* lds, int wid, int lane) {
    asm volatile("s_waitcnt vmcnt(0)" ::: "memory");
    const int idx = g.pos, e = BG_E0 + idx / BG_PER_E, r = idx % BG_PER_E, nsl = r >> 4, kb = r & 15;
    const int nbase = 128 * nsl, drow = (nbase < 2048 ? 256 * (nbase >> 7) : 256 * ((nbase - 2048) >> 7) + 128) + 16 * wid;
    const int n = lane & 15, kq = lane >> 4;
    const ATT_LAS float* sl = (const ATT_LAS float*)(lds + L_BG + wid * BG_SLOT) + (16 * kq) * 16 + n;
    unsigned char* dst = g.w8 + (size_t)e * 4096 * 2048 + (size_t)(drow + n) * 2048 + 128 * kb + 16 * kq;
    const float sc = g.scale;
#pragma unroll
    for (int rd = 0; rd < 2; ++rd) { float v[16];
#pragma unroll
        for (int k = 0; k < 16; ++k) v[k] = sl[(64 * rd + k) * 16] * sc;
        typedef unsigned u32x4_t __attribute__((ext_vector_type(4))); u32x4_t o;
        o.x = __builtin_amdgcn_cvt_pk_fp8_f32(v[2], v[3], __builtin_amdgcn_cvt_pk_fp8_f32(v[0], v[1], 0u, false), true);
        o.y = __builtin_amdgcn_cvt_pk_fp8_f32(v[6], v[7], __builtin_amdgcn_cvt_pk_fp8_f32(v[4], v[5], 0u, false), true);
        o.z = __builtin_amdgcn_cvt_pk_fp8_f32(v[10], v[11], __builtin_amdgcn_cvt_pk_fp8_f32(v[8], v[9], 0u, false), true);
        o.w = __builtin_amdgcn_cvt_pk_fp8_f32(v[14], v[15], __builtin_amdgcn_cvt_pk_fp8_f32(v[12], v[13], 0u, false), true);
        *(u32x4_t*)(dst + 64 * rd) = o; }
}
__host__ __device__ __forceinline__ unsigned off_a(unsigned row, unsigned ch) { return 2048u * (row >> 3) + 512u * (ch >> 2) + 64u * (row & 7) + 16u * ((ch & 3) ^ ((row >> 2) & 3)); }
__device__ __forceinline__ int crow(int r, int hi) { return (r & 3) + 8 * (r >> 2) + 4 * hi; }
__device__ __forceinline__ unsigned cvtpk(float lo, float hi) { unsigned r; asm volatile("v_cvt_pk_bf16_f32 %0, %1, %2" : "=v"(r) : "v"(lo), "v"(hi)); return r; }
typedef short v4i16_t __attribute__((ext_vector_type(4)));
__device__ __forceinline__ s16x4 vtr(const ATT_LAS char* p) { return __builtin_bit_cast(s16x4, __builtin_amdgcn_ds_read_tr16_b64_v4i16((ATT_LAS v4i16_t*)p)); }
struct Job { const bf16_t* Q; const bf16_t* K; const bf16_t* V; bf16_t* O; const float* nb; const float* tab; int fox; };

__device__ __forceinline__ void attn_unit(ATT_LAS char* lds, const Job& J, int b, int qb, Bg& bg) {
    int tid_o = threadIdx.x; asm volatile("" : "+v"(tid_o));
    const int tid = tid_o, lane = tid & 63, r32 = lane & 31, hi = lane >> 5; const int wid = __builtin_amdgcn_readfirstlane(tid >> 6);
    const int i0w = 256 * qb + 32 * wid;
    const int NT = 4 * qb + 5;
    ATT_LAS float* wsf = (ATT_LAS float*)(lds + L_WSF) + wid * 64;
    ATT_LAS float* tabl = (ATT_LAS float*)(lds + L_TAB);
    bf16x8 qr[8];
    { const bf16_t* qp = J.Q + (size_t)(b * NQ_PER_B + i0w + r32) * PITCH + 8 * hi;
#pragma unroll
      for (int ks = 0; ks < 8; ++ks) qr[ks] = *(const bf16x8*)(qp + 16 * ks); }
    f32x16 o[4];
#pragma unroll
    for (int c = 0; c < 4; ++c)
#pragma unroll
        for (int r = 0; r < 16; ++r) o[c][r] = 0.f;
    float mrun = -1e30f, lrun = 0.f;
    const int srow = tid >> 4, sch = tid & 15;
    const bf16_t* kg = J.K + (size_t)(b * KV_PER_B + srow) * PITCH + sch * 8;
    const bf16_t* vg = J.V + (size_t)(b * KV_PER_B + srow) * PITCH + sch * 8;
    const unsigned st0 = off_a(srow, sch), st1 = off_a(srow + 32, sch);
    const float* nbg = J.nb + (size_t)b * KV_PER_B;
    if (!J.fox && tid < 128) tabl[tid] = J.tab[tid];
    const unsigned y = (r32 >> 2) & 3;
    const unsigned kb0 = 2048u * (r32 >> 3) + 64u * (r32 & 7) + 16u * ((unsigned)hi ^ y), kb1 = 2048u * (r32 >> 3) + 64u * (r32 & 7) + 16u * (((unsigned)hi ^ y) ^ 2u);
    const unsigned q4 = (lane & 15) >> 2, p4 = lane & 3, b16 = (lane >> 4) & 1;
    const unsigned vb0 = 64u * (4u * hi + q4) + 16u * (2u * (b16 ^ 0u) + ((p4 >> 1) ^ (unsigned)hi)) + 8u * (p4 & 1);
    const unsigned vb1 = 2048u + 64u * (4u * hi + q4) + 16u * (2u * (b16 ^ 1u) + ((p4 >> 1) ^ (unsigned)hi)) + 8u * (p4 & 1);
    bf16x8 sk0, sk1, sv0, sv1; float snb = 0.f;
    sk0 = *(const bf16x8*)(kg); sk1 = *(const bf16x8*)(kg + 32 * PITCH); sv0 = *(const bf16x8*)(vg); sv1 = *(const bf16x8*)(vg + 32 * PITCH);
    if (J.fox && tid < 64) snb = nbg[tid];
    *(ATT_LAS bf16x8*)(lds + L_K + st0) = sk0; *(ATT_LAS bf16x8*)(lds + L_K + st1) = sk1; *(ATT_LAS bf16x8*)(lds + L_V + st0) = sv0; *(ATT_LAS bf16x8*)(lds + L_V + st1) = sv1;
    if (J.fox && tid < 64) ((ATT_LAS float*)(lds + L_NB))[tid] = snb;
    __syncthreads();
    for (int t = 0; t < NT; ++t) {
        const int buf = t & 1;
        const bool more = (t + 1 < NT);
        const bool bgon = bg.pos < bg.end;
        if (bgon) bg_issue(bg, lds, wid, lane);
        if (more) { const size_t go = (size_t)(t + 1) * 64 * PITCH;
            sk0 = *(const bf16x8*)(kg + go); sk1 = *(const bf16x8*)(kg + go + 32 * PITCH); sv0 = *(const bf16x8*)(vg + go); sv1 = *(const bf16x8*)(vg + go + 32 * PITCH);
            if (J.fox && tid < 64) snb = nbg[(t + 1) * 64 + tid]; }
        const int j0 = 64 * (t - 1);
        const bool skip = (t > 0) && (j0 > i0w + 31);
        if (!skip) {
            const ATT_LAS char* Kb = lds + L_K + buf * 16384; const ATT_LAS char* Vb = lds + L_V + buf * 16384;
            f32x16 p0, p1;
            const float mref = (t == 0) ? 0.f : mrun;
            if (J.fox) {
                const ATT_LAS float* nbl = (const ATT_LAS float*)(lds + L_NB) + buf * 64 + 4 * hi;
#pragma unroll
                for (int g = 0; g < 4; ++g) { const f32x4 a = *(const ATT_LAS f32x4*)(nbl + 8 * g), c = *(const ATT_LAS f32x4*)(nbl + 32 + 8 * g);
#pragma unroll
                    for (int e = 0; e < 4; ++e) { p0[4 * g + e] = a[e] - mref; p1[4 * g + e] = c[e] - mref; } }
            } else {
                const bool near = (t == 0) ? (i0w < 112) : (i0w - j0 < 176);
                if (near) { const int dbase = (t == 0) ? (16 + i0w + r32) : (i0w + r32 - j0);
#pragma unroll
                    for (int r = 0; r < 16; ++r) { int d0 = dbase - crow(r, hi), d1 = d0 - 32; d0 = d0 < 0 ? 0 : (d0 > 127 ? 127 : d0); d1 = d1 < 0 ? 0 : (d1 > 127 ? 127 : d1); p0[r] = tabl[d0] - mref; p1[r] = tabl[d1] - mref; }
                } else { const float cf = tabl[127] - mref;
#pragma unroll
                    for (int r = 0; r < 16; ++r) { p0[r] = cf; p1[r] = cf; } }
            }
#pragma unroll
            for (int ks = 0; ks < 8; ++ks) { const unsigned kb = ((ks & 1) ? kb1 : kb0) + 512u * (ks >> 1);
                const bf16x8 a0 = *(const ATT_LAS bf16x8*)(Kb + kb), a1 = *(const ATT_LAS bf16x8*)(Kb + kb + 8192);
                p0 = __builtin_amdgcn_mfma_f32_32x32x16_bf16(a0, qr[ks], p0, 0, 0, 0); p1 = __builtin_amdgcn_mfma_f32_32x32x16_bf16(a1, qr[ks], p1, 0, 0, 0);
                if ((ks & 3) == 3) __builtin_amdgcn_sched_barrier(0); }
            const float NEG = -__builtin_inff();
            if (t == 0) {
#pragma unroll
                for (int r = 8; r < 16; ++r) p0[r] = NEG;
#pragma unroll
                for (int r = 0; r < 16; ++r) p1[r] = NEG;
            } else if (j0 + 63 > i0w) { const int lim = i0w + r32 - j0;
#pragma unroll
                for (int r = 0; r < 16; ++r) { const int kk = crow(r, hi); if (kk > lim) p0[r] = NEG; if (kk + 32 > lim) p1[r] = NEG; } }
            float rm = __builtin_fmaxf(__builtin_fmaxf(p0[0], p0[1]), p0[2]), rm1 = __builtin_fmaxf(__builtin_fmaxf(p1[0], p1[1]), p1[2]);
#pragma unroll
            for (int r = 3; r < 15; r += 2) { rm = __builtin_fmaxf(__builtin_fmaxf(rm, p0[r]), p0[r + 1]); rm1 = __builtin_fmaxf(__builtin_fmaxf(rm1, p1[r]), p1[r + 1]); }
            rm = __builtin_fmaxf(__builtin_fmaxf(rm, rm1), fmaxf(p0[15], p1[15]));
            { auto rr = __builtin_amdgcn_permlane32_swap(__float_as_uint(rm), __float_as_uint(rm), false, false); rm = fmaxf(__uint_as_float(rr[0]), __uint_as_float(rr[1])); }
            const float mn = rm + mref; const bool need = mn > mrun + THR;
            if (__any(need)) {
                const float alpha = need ? __builtin_amdgcn_exp2f(mrun - mn) : 1.0f, sub = need ? rm : 0.f; mrun = need ? mn : mrun; lrun *= alpha;
                if (hi == 0) wsf[r32] = alpha;
                asm volatile("s_waitcnt lgkmcnt(0)" ::: "memory");
#pragma unroll
                for (int r = 0; r < 16; ++r) { const float a = wsf[crow(r, hi)]; p0[r] -= sub; p1[r] -= sub;
#pragma unroll
                    for (int c = 0; c < 4; ++c) o[c][r] *= a; }
            }
            float ls = 0.f;
#pragma unroll
            for (int r = 0; r < 16; ++r) { p0[r] = __builtin_amdgcn_exp2f(p0[r]); p1[r] = __builtin_amdgcn_exp2f(p1[r]); ls += p0[r] + p1[r]; }
            lrun += ls;
            bf16x8 pa[4];
#pragma unroll
            for (int s = 0; s < 4; ++s) { const f32x16& P = (s < 2) ? p0 : p1; const int bb = (s & 1) * 8;
                const unsigned w0 = cvtpk(P[bb + 0], P[bb + 1]), w1 = cvtpk(P[bb + 2], P[bb + 3]), w2 = cvtpk(P[bb + 4], P[bb + 5]), w3 = cvtpk(P[bb + 6], P[bb + 7]);
                typedef unsigned u32x4_t __attribute__((ext_vector_type(4))); const u32x4_t w = {w0, w1, w2, w3}; pa[s] = __builtin_bit_cast(bf16x8, w); }
#pragma unroll
            for (int c = 0; c < 4; ++c)
#pragma unroll
                for (int s = 0; s < 4; ++s) { const s16x4 lo = vtr(Vb + vb0 + 4096u * s + 512u * c), hh = vtr(Vb + vb1 + 4096u * s + 512u * c);
                    const bf16x8 vv = {lo[0], lo[1], lo[2], lo[3], hh[0], hh[1], hh[2], hh[3]};
                    o[c] = __builtin_amdgcn_mfma_f32_32x32x16_bf16(pa[s], vv, o[c], 0, 0, 0); if (s == 3) __builtin_amdgcn_sched_barrier(0); }
        }
        if (more) { const int nb_ = buf ^ 1;
            *(ATT_LAS bf16x8*)(lds + L_K + nb_ * 16384 + st0) = sk0; *(ATT_LAS bf16x8*)(lds + L_K + nb_ * 16384 + st1) = sk1; *(ATT_LAS bf16x8*)(lds + L_V + nb_ * 16384 + st0) = sv0; *(ATT_LAS bf16x8*)(lds + L_V + nb_ * 16384 + st1) = sv1;
            if (J.fox && tid < 64) ((ATT_LAS float*)(lds + L_NB))[nb_ * 64 + tid] = snb; }
        if (bgon) bg_consume(bg, lds, wid, lane);
        ++bg.pos;
        asm volatile("s_waitcnt lgkmcnt(0)\n\ts_barrier" ::: "memory");
    }
    { auto rr = __builtin_amdgcn_permlane32_swap(__float_as_uint(lrun), __float_as_uint(lrun), false, false); lrun = __uint_as_float(rr[0]) + __uint_as_float(rr[1]); }
    if (hi == 0) wsf[32 + r32] = lrun;
    asm volatile("s_waitcnt lgkmcnt(0)" ::: "memory");
    bf16_t* Ow = J.O + (size_t)(b * NQ_PER_B + i0w) * PITCH;
    unsigned voff = (unsigned)(4 * hi * PITCH + r32); asm volatile("" : "+v"(voff));
#pragma unroll
    for (int r = 0; r < 16; ++r) { const float rl = __builtin_amdgcn_rcpf(wsf[32 + crow(r, hi)]);
#pragma unroll
        for (int c = 0; c < 4; ++c) { const unsigned w = cvtpk(o[c][r] * rl, 0.f); Ow[voff + (unsigned)(((r & 3) + 8 * (r >> 2)) * PITCH + 32 * c)] = (bf16_t)(w & 0xffffu); } }
    __syncthreads();
}
}
#ifndef MK_N_LAUNCHES
#define MK_N_LAUNCHES 1
#endif
constexpr int NWAVES = 8;
constexpr int NPHASE = 12;
constexpr int DM = 2048, NB = 4, SEQ = 2048, NMETA = 16, MTOK = NB * SEQ;
constexpr int DIN = 10248, NPROJ = 10240;
constexpr int KVB = 2112;
constexpr int NEXP = 32, TOPK = 4, DEXP = 2048, ECAP = 8192;
constexpr float RMS_EPS = 1e-5f, LOG2E = 1.4426950408889634f;
constexpr float QSCALE = 0.08838834764831845f * 1.4426950408889634f;
constexpr float LAMBDA_INIT = 0.2f;
constexpr size_t MiB = 1u << 20;
constexpr size_t WS_CTL = 0, CTL_ZERO_BYTES = 1 * MiB;
constexpr size_t WS_SMALL = 1 * MiB;
constexpr size_t WS_LOGF = 2 * MiB;
constexpr size_t WS_NB = 3 * MiB;
constexpr size_t WS_TOPI = 4 * MiB, WS_GATE = WS_TOPI + 256 * 1024, WS_RANK = WS_GATE + 256 * 1024;
constexpr size_t WS_WIN = 8 * MiB, WS_WBF = 48 * MiB, WS_WBD = 52 * MiB, WS_WOUT = 56 * MiB, WS_WGU = 64 * MiB, WS_WD = 576 * MiB;
constexpr size_t WS_XN = 832 * MiB, WS_QF = 866 * MiB, WS_KF = 882 * MiB, WS_VF = 899 * MiB, WS_QD = 916 * MiB, WS_KD = 932 * MiB, WS_VD = 949 * MiB;
constexpr size_t WS_GF = 966 * MiB, WS_GD = 998 * MiB, WS_OFOX = 1030 * MiB, WS_ODIFF = 1046 * MiB, WS_AD0 = 1062 * MiB, WS_AD1 = 1078 * MiB;
constexpr size_t WS_T1 = 1094 * MiB, WS_MERGED = 1126 * MiB, WS_H1 = 1158 * MiB, WS_XN2 = 1222 * MiB, WS_XS = 1254 * MiB, WS_ACT = 1766 * MiB, WS_YS = 2278 * MiB, WS_END = 3302 * MiB;
static_assert(WS_WIN + (size_t)NPROJ * DM * 2 <= WS_WBF && WS_WGU + (size_t)NEXP * 4096 * DM * 2 <= WS_WD && WS_WD + (size_t)NEXP * DM * DM * 2 <= WS_XN, "ws map (weights)");
static_assert(WS_XN + (size_t)(MTOK + 256) * DM * 2 <= WS_QF && WS_KF + (size_t)NB * KVB * 1024 * 2 <= WS_VF && WS_XS + (size_t)NEXP * ECAP * DM <= WS_ACT && WS_ACT + (size_t)NEXP * ECAP * DM <= WS_YS && WS_YS + (size_t)NEXP * ECAP * DM * 2 <= WS_END, "ws map (activations)");
constexpr int CW_BAR = 4096;
constexpr int CW_AQ = 8192;
constexpr int CW_ST = 16384;
constexpr int CW_CNT = 8448;
constexpr int RING_OFF = 0, RING_BYTES = 131072;
constexpr int P0_SCR = 16640;
constexpr int MOE_OFF = 135168;
constexpr int MOE_BYTES = 1024;
constexpr int MISC_OFF = MOE_OFF + MOE_BYTES;
constexpr int BGW_OFF = RING_BYTES;
constexpr int LDS_BYTES = 163840;
static_assert(MISC_OFF + 128 <= LDS_BYTES, "LDS map");

#define GAS __attribute__((address_space(1)))
#define LAS __attribute__((address_space(3)))
typedef unsigned short bf16;
typedef unsigned v4u __attribute__((ext_vector_type(4)));
typedef unsigned v2u __attribute__((ext_vector_type(2)));
typedef float f32x4 __attribute__((ext_vector_type(4)));
typedef float f32x16 __attribute__((ext_vector_type(16)));
typedef short bf16x8 __attribute__((ext_vector_type(8)));
typedef GAS unsigned gu32;
#define RLX_AGENT __ATOMIC_RELAXED, __HIP_MEMORY_SCOPE_AGENT
#define LDS_WAIT() asm volatile("s_waitcnt lgkmcnt(0)" ::: "memory")
#define VM_WAIT() asm volatile("s_waitcnt vmcnt(0)" ::: "memory")
__device__ __forceinline__ unsigned f2bf(float f) { unsigned u = __builtin_bit_cast(unsigned, f); return (u + 0x7fffu + ((u >> 16) & 1u)) >> 16; }
__device__ __forceinline__ unsigned pk2(float lo, float hi) { return f2bf(lo) | (f2bf(hi) << 16); }
__device__ __forceinline__ float bflo(unsigned w) { return __uint_as_float(w << 16); }
__device__ __forceinline__ float bfhi(unsigned w) { return __uint_as_float(w & 0xffff0000u); }

#define XB_TMO      128
#define XB_XCNT(j)  (256  + 64 * (j))
#define XB_XSUB(j)  (1280 + 64 * (j))
#define XB_XGEN(j)  (2304 + 64 * (j))
#define XB_TOP      3328
#define XB_TOPGEN   3392
#define XCD_BAR_WORDS 3456
#define XB_SPIN_CAP (1u << 18)

__device__ __forceinline__ unsigned xb_ld(unsigned* p)              { return __hip_atomic_load(p, __ATOMIC_RELAXED, __HIP_MEMORY_SCOPE_AGENT); }
__device__ __forceinline__ unsigned xb_add(unsigned* p, unsigned v) { return __hip_atomic_fetch_add(p, v, __ATOMIC_RELAXED, __HIP_MEMORY_SCOPE_AGENT); }
__device__ __forceinline__ unsigned xb_xcc_id() { return (unsigned)__builtin_amdgcn_s_getreg((3 << 11) | 20) & 0xFu; }
#define XB_SPIN(cond, bar) do { unsigned _sp = 0; while (cond) { __builtin_amdgcn_s_sleep(1); \
    if ((++_sp & 255u) == 0u) { if (xb_ld(&(bar)[XB_TMO])) break; if (_sp > XB_SPIN_CAP) { atomicAdd(&(bar)[XB_TMO], 1u); break; } } } } while (0)

struct XcdBarrier {
    unsigned* bar; unsigned x;
    volatile unsigned* st;
};

__device__ __forceinline__ XcdBarrier xcd_barrier_post(unsigned* bar, volatile unsigned* st) {
    XcdBarrier b; b.bar = bar; b.x = xb_xcc_id(); b.st = st;
    if (threadIdx.x == 0) (void)xb_add(&bar[XB_XCNT(b.x)], 1u);
    return b;
}
__device__ __forceinline__ void xcd_barrier_complete(unsigned* bar, unsigned x, unsigned& nloc, unsigned& nx) {
    const unsigned G = gridDim.x * gridDim.y * gridDim.z;
    unsigned sum, cnt, mine, sp = 0u;
    for (;;) {
        sum = 0u; cnt = 0u; mine = 0u;
#pragma unroll
        for (unsigned j = 0; j < 16; ++j) { const unsigned c = xb_ld(&bar[XB_XCNT(j)]); sum += c; cnt += (c > 0u) ? 1u : 0u; mine = (j == x) ? c : mine; }
        if (sum == G) break;
        __builtin_amdgcn_s_sleep(1);
        if ((++sp & 255u) == 0u) { if (xb_ld(&bar[XB_TMO])) break; if (sp > XB_SPIN_CAP) { atomicAdd(&bar[XB_TMO], 1u); break; } }
    }
    nloc = mine > 0u ? mine : 1u; nx = cnt > 0u ? cnt : 1u;
}

__device__ __forceinline__ void xcd_barrier(const XcdBarrier& b) {
    asm volatile("s_waitcnt vmcnt(0)" ::: "memory");
    __syncthreads();
    if (threadIdx.x == 0) {
        unsigned* bar = b.bar;
        __builtin_amdgcn_s_waitcnt(0);
        unsigned nloc = b.st[0], nx = b.st[1];
        if (nloc == 0u) { xcd_barrier_complete(bar, b.x, nloc, nx); b.st[0] = nloc; b.st[1] = nx; }
        const unsigned old = xb_add(&bar[XB_XSUB(b.x)], 1u);
        const unsigned gen = old / nloc;
        if (old + 1u == (gen + 1u) * nloc) {
            __builtin_amdgcn_fence(__ATOMIC_RELEASE, "agent");
            asm volatile("s_waitcnt vmcnt(0)" ::: "memory");
            const unsigned og = xb_add(&bar[XB_TOP], 1u);
            const unsigned tg = og / nx;
            if (og + 1u == (tg + 1u) * nx) xb_add(&bar[XB_TOPGEN], 1u);
            else XB_SPIN(xb_ld(&bar[XB_TOPGEN]) == tg, bar);
            __builtin_amdgcn_fence(__ATOMIC_ACQUIRE, "agent");
            xb_add(&bar[XB_XGEN(b.x)], 1u);
            asm volatile("s_waitcnt vmcnt(0)" ::: "memory");
        } else {
            XB_SPIN(xb_ld(&bar[XB_XGEN(b.x)]) == gen, bar);
            __builtin_amdgcn_fence(__ATOMIC_ACQUIRE, "agent");
            asm volatile("s_waitcnt vmcnt(0)" ::: "memory");
        }
    }
    __syncthreads();
}

__device__ __forceinline__ float wave_sum(float v) {
#pragma unroll
    for (int o = 1; o < 64; o <<= 1) v += __shfl_xor(v, o);
    return v;
}
struct TrB { const float* src; bf16* dst; int ldw, K; };
__device__ __forceinline__ TrB trb_make(const float* W, int ldw, int K, bf16* WT, int src_col0, int dst_row0, int kb, int lane) {
    const int nl = lane & 7, kq = lane >> 3; TrB t; t.ldw = ldw; t.K = K;
    t.src = W + (size_t)(64 * kb + 8 * kq) * ldw + src_col0 + 4 * nl; t.dst = WT + (size_t)(dst_row0 + 4 * nl) * K + 64 * kb + 8 * kq; return t;
}
__device__ __forceinline__ void trb_load(f32x4 (&v)[8], const TrB& t) {
#pragma unroll
    for (int r = 0; r < 8; ++r) v[r] = __builtin_nontemporal_load((const GAS f32x4*)(t.src + (size_t)r * t.ldw));
}
__device__ __forceinline__ void trb_store(const f32x4 (&v)[8], const TrB& t) {
#pragma unroll
    for (int j = 0; j < 4; ++j) { v4u o; o.x = pk2(v[0][j], v[1][j]); o.y = pk2(v[2][j], v[3][j]); o.z = pk2(v[4][j], v[5][j]); o.w = pk2(v[6][j], v[7][j]);
        *(GAS v4u*)(t.dst + (size_t)j * t.K) = o; }
}
struct TrItem { const float* src; unsigned char* dst; };
__device__ __forceinline__ void tr8_load(f32x4 (&v)[16], const float* src, int ldw) {
#pragma unroll
    for (int r = 0; r < 16; ++r) v[r] = __builtin_nontemporal_load((const GAS f32x4*)(src + (size_t)r * ldw));
}
__device__ __forceinline__ void tr8_store(const f32x4 (&v)[16], unsigned char* dst, int Kb, float scale) {
#pragma unroll
    for (int j = 0; j < 4; ++j) { v4u o;
        o.x = __builtin_amdgcn_cvt_pk_fp8_f32(v[2][j] * scale, v[3][j] * scale, __builtin_amdgcn_cvt_pk_fp8_f32(v[0][j] * scale, v[1][j] * scale, 0u, false), true);
        o.y = __builtin_amdgcn_cvt_pk_fp8_f32(v[6][j] * scale, v[7][j] * scale, __builtin_amdgcn_cvt_pk_fp8_f32(v[4][j] * scale, v[5][j] * scale, 0u, false), true);
        o.z = __builtin_amdgcn_cvt_pk_fp8_f32(v[10][j] * scale, v[11][j] * scale, __builtin_amdgcn_cvt_pk_fp8_f32(v[8][j] * scale, v[9][j] * scale, 0u, false), true);
        o.w = __builtin_amdgcn_cvt_pk_fp8_f32(v[14][j] * scale, v[15][j] * scale, __builtin_amdgcn_cvt_pk_fp8_f32(v[12][j] * scale, v[13][j] * scale, 0u, false), true);
        *(GAS v4u*)(dst + (size_t)j * Kb) = o; }
}
__device__ __forceinline__ TrItem tr8_item(int r, const float* w_gu, const float* w_dn, unsigned char* WGU8, unsigned char* WD8, int lane, int& ldw) {
    constexpr int I_GU = 16 * 128, I_DN = 16 * 64; TrItem t; const int nl = lane & 7, kq = lane >> 3;
    if (r < att::BG_E0 * I_GU) { const int e = r / I_GU, q = r % I_GU, kb = q / 128, n0 = 32 * (q % 128);
        const int drow = n0 < 2048 ? 256 * (n0 >> 7) + (n0 & 127) : 256 * ((n0 - 2048) >> 7) + 128 + (n0 & 127);
        ldw = 4096; t.src = w_gu + (size_t)e * DM * 4096 + (size_t)(128 * kb + 16 * kq) * 4096 + n0 + 4 * nl; t.dst = WGU8 + (size_t)e * 4096 * DM + (size_t)(drow + 4 * nl) * DM + 128 * kb + 16 * kq; }
    else { r -= att::BG_E0 * I_GU; const int e = r / I_DN, q = r % I_DN, kb = q / 64, n0 = 32 * (q % 64);
        ldw = DM; t.src = w_dn + (size_t)e * DM * DM + (size_t)(128 * kb + 16 * kq) * DM + n0 + 4 * nl; t.dst = WD8 + (size_t)e * DM * DM + (size_t)(n0 + 4 * nl) * DM + 128 * kb + 16 * kq; }
    return t;
}
__device__ __forceinline__ float log_sigmoid(float z) { return fminf(z, 0.f) - log1pf(expf(-fabsf(z))); }

struct Args { const float* in[22]; float* out; unsigned char* ws; int ph_lo, ph_hi; };

__device__ __forceinline__ void moe_tables(LAS int* mt, const gu32* ctl, int tid) {
    if (tid == 0) { int acc = 0;
        for (int e = 0; e < NEXP; ++e) { const int c = (int)__hip_atomic_load(ctl + CW_CNT + 32 * e, RLX_AGENT); const int n = (c + 255) >> 8; mt[e] = acc; mt[32 + e] = n; mt[128 + e] = c; acc += n; }
        mt[64] = acc; }
    __syncthreads();
}
__device__ __forceinline__ int moe_build_list(LAS int* mt, int nct, int G, int c, int tid) {
    LAS int* list = mt + 72;
    if (tid == 0) { const int T = mt[64], U = T * nct; int n = 0;
        const int R = U / G, Lv = U - R * G; const bool split = Lv > 0 && 2 * Lv <= G && (G & 15) == 0;
        for (int i = 0; i < 24; ++i) { long L = (long)i * G + c; int part = -1;
            if (split && i == R) { const int j = (c >> 4) * 8 + (c & 7); if (j >= Lv) break; part = (c >> 3) & 1; L = (long)R * G + j; }
            if (L >= U) break;
            int wg = (int)L; { const int q = U / 8, r = U % 8, xcd = wg % 8, off = wg / 8; wg = (xcd < r ? xcd * (q + 1) : r * (q + 1) + (xcd - r) * q) + off; }
            int e = 0; while (e < NEXP - 1 && wg >= (mt[e] + mt[32 + e]) * nct) ++e;
            const int local = wg - mt[e] * nct, ne = mt[32 + e]; const int tt = local % ne; int hf = (mt[128 + e] - 256 * tt <= 128) ? 1 : 0;
            if (part >= 0) { if (hf) { if (part == 1) break; } else hf = 1; }
            list[2 * n] = 2 * (e * (ECAP / 256) + tt) + (part == 1 ? 1 : 0); list[2 * n + 1] = (e * nct + local / ne) | (hf << 16); ++n; }
        mt[65] = n; }
    __syncthreads();
    return mt[65];
}

__global__ void __launch_bounds__(NWAVES * 64, 2) hyb_fwd(Args args) {
    extern __shared__ __attribute__((aligned(16))) unsigned char lds_raw[];
    LAS unsigned char* lds = (LAS unsigned char*)lds_raw;
    volatile LAS unsigned* MISC = (volatile LAS unsigned*)(lds + MISC_OFF);
    LAS int* mt = (LAS int*)(lds + MOE_OFF);
    const int tid = threadIdx.x, lane = tid & 63, wave = __builtin_amdgcn_readfirstlane(tid >> 6);
    const int G = gridDim.x, bx = blockIdx.x;
    const int vcu = (G % 8 == 0) ? (bx % 8) * (G / 8) + bx / 8 : bx;
    const int gw = vcu * NWAVES + wave, NGW = G * NWAVES;
    unsigned char* ws = args.ws;
    gu32* ctl = (gu32*)(ws + WS_CTL);
    const float* x = args.in[0]; const float* meta = args.in[1]; const float* relb = args.in[2]; const float* g_attn = args.in[3]; const float* w_in = args.in[4];
    const float* ffb = args.in[5]; const float* lq1 = args.in[6]; const float* lk1 = args.in[7]; const float* lq2 = args.in[8]; const float* lk2 = args.in[9];
    const float* subln = args.in[10]; const float* w_bf = args.in[11]; const float* w_bd = args.in[12]; const float* w_out = args.in[13]; const float* g_ffn = args.in[14];
    const float* w_router = args.in[15]; const float* b_router = args.in[16]; const float* w_gu = args.in[17]; const float* b_gu = args.in[18]; const float* w_dn = args.in[19];
    const float* b_dn = args.in[20]; const float* g_fin = args.in[21];
    float* TAB = (float*)(ws + WS_SMALL); float* LAMP = (float*)(ws + WS_SMALL + 2048); float* LOGFM = (float*)(ws + WS_SMALL + 4096);
    float* LOGF = (float*)(ws + WS_LOGF); float* NBIAS = (float*)(ws + WS_NB);
    int* TOPI = (int*)(ws + WS_TOPI); float* GATE = (float*)(ws + WS_GATE); int* RANK = (int*)(ws + WS_RANK);
    int* ROWTOK = (int*)(ws + WS_XS + 32 * MiB);
    bf16 *WIN = (bf16*)(ws + WS_WIN), *WBF = (bf16*)(ws + WS_WBF), *WBD = (bf16*)(ws + WS_WBD), *WOUT = (bf16*)(ws + WS_WOUT), *WGU = (bf16*)(ws + WS_WGU), *WD = (bf16*)(ws + WS_WD);
    unsigned char *WGU8 = ws + WS_WGU, *WD8 = ws + WS_WD, *XN28 = ws + WS_XN2, *XS8 = ws + WS_XS, *ACT8 = ws + WS_ACT;
    bf16 *XN = (bf16*)(ws + WS_XN), *QF = (bf16*)(ws + WS_QF), *KF = (bf16*)(ws + WS_KF), *VF = (bf16*)(ws + WS_VF), *QD = (bf16*)(ws + WS_QD), *KD = (bf16*)(ws + WS_KD), *VD = (bf16*)(ws + WS_VD);
    bf16 *GF = (bf16*)(ws + WS_GF), *GD = (bf16*)(ws + WS_GD), *OFOX = (bf16*)(ws + WS_OFOX), *AD0 = (bf16*)(ws + WS_AD0), *AD1 = (bf16*)(ws + WS_AD1), *ODIFF = (bf16*)(ws + WS_ODIFF);
    bf16 *T1 = (bf16*)(ws + WS_T1), *MERGED = (bf16*)(ws + WS_MERGED), *XN2 = (bf16*)(ws + WS_XN2), *XS = (bf16*)(ws + WS_XS), *ACT = (bf16*)(ws + WS_ACT); unsigned char* YS = ws + WS_YS;
    float* H1 = (float*)(ws + WS_H1);

    for (int u = tid; u < (LDS_BYTES - MOE_OFF) / 4; u += NWAVES * 64) ((LAS unsigned*)(lds + MOE_OFF))[u] = 0u;
    __syncthreads();
    XcdBarrier bar; bar.bar = (unsigned*)(ctl + CW_BAR); bar.x = 0; bar.st = nullptr;
    if (MK_N_LAUNCHES == 1) bar = xcd_barrier_post((unsigned*)(ctl + CW_BAR), (volatile unsigned*)(ctl + CW_ST + 2 * bx));
    const int lo = args.ph_lo, hi = args.ph_hi;
#ifndef PHMASK
#define PHMASK 0xFFF
#endif
#define IN(k) (((PHMASK >> (k)) & 1) && lo <= (k) && (k) < hi)
#ifndef REPMASK
#define REPMASK 0
#endif
#define REPS(k) ((((REPMASK) >> (k)) & 1) ? 2 : 1)
#define SEAM(k) do { if (IN(k) && IN((k) + 1)) xcd_barrier(bar); } while (0)

    if (IN(0)) for (int rep_ = 0; rep_ < REPS(0); ++rep_) { if (rep_) xcd_barrier(bar);
        int tid_o = threadIdx.x; asm volatile("" : "+v"(tid_o)); const int tid = tid_o, lane = tid_o & 63;
        LAS float* scr = (LAS float*)(lds + RING_OFF + wave * P0_SCR);
        LAS float* wff = (LAS float*)(lds + RING_OFF);
        { float tw[32];
#pragma unroll
          for (int q = 0; q < 32; ++q) { const int i = tid + q * NWAVES * 64; tw[q] = w_in[(size_t)(i >> 3) * DIN + 3072 + (i & 7)]; }
#pragma unroll
          for (int q = 0; q < 32; ++q) { const int i = tid + q * NWAVES * 64; wff[(i & 7) * DM + (i >> 3)] = tw[q]; } }
        __syncthreads();
        constexpr int I_IN = 32 * (NPROJ / 32), I_BF = 16 * 64, I_OUT = 32 * 64;
        constexpr int NITEMS = I_IN + 2 * I_BF + I_OUT;
#define TRB_ITEM(it_) ((it_) < I_IN ? trb_make(w_in, DIN, DM, WIN, (32 * ((it_) % (NPROJ / 32))) < 3072 ? 32 * ((it_) % (NPROJ / 32)) : 32 * ((it_) % (NPROJ / 32)) + 8, 32 * ((it_) % (NPROJ / 32)), (it_) / (NPROJ / 32), lane) \
        : (it_) < I_IN + I_BF ? trb_make(w_bf, DM, 1024, WBF, 32 * (((it_) - I_IN) % 64), 32 * (((it_) - I_IN) % 64), ((it_) - I_IN) / 64, lane) \
        : (it_) < I_IN + 2 * I_BF ? trb_make(w_bd, DM, 1024, WBD, 32 * (((it_) - I_IN - I_BF) % 64), 32 * (((it_) - I_IN - I_BF) % 64), ((it_) - I_IN - I_BF) / 64, lane) \
        : trb_make(w_out, DM, DM, WOUT, 32 * (((it_) - I_IN - 2 * I_BF) % 64), 32 * (((it_) - I_IN - 2 * I_BF) % 64), ((it_) - I_IN - 2 * I_BF) / 64, lane))
        { f32x4 va[8], vb[8]; TrB ta, tb; int it = gw;
          if (it < NITEMS) { ta = TRB_ITEM(it); trb_load(va, ta); }
          while (it < NITEMS) {
              const int it1 = it + NGW; if (it1 < NITEMS) { tb = TRB_ITEM(it1); trb_load(vb, tb); }
              trb_store(va, ta);
              if (it1 >= NITEMS) break;
              const int it2 = it1 + NGW; if (it2 < NITEMS) { ta = TRB_ITEM(it2); trb_load(va, ta); }
              trb_store(vb, tb);
              it = it2; } }
#undef TRB_ITEM
        { const int ROWS_END = MTOK + NMETA; int m = gw < MTOK ? gw : ROWS_END; f32x4 v[8], vn[8], vnn[8], gA[8]; const float ffbv = ffb[lane & 7];
#pragma unroll
          for (int j = 0; j < 8; ++j) gA[j] = *((const GAS f32x4*)g_attn + 64 * j + lane);
          auto next_row = [&](int r) { if (r >= MTOK) return ROWS_END; const int n = r + NGW; return n < MTOK ? n : ((gw >= 64 && gw < 64 + NMETA) ? MTOK + gw - 64 : ROWS_END); };
#define P0_LOADROW(dst_, r_) do { if ((r_) < ROWS_END) { const GAS f32x4* xr_ = (const GAS f32x4*)(((r_) < MTOK) ? x + (size_t)(r_) * DM : meta + (size_t)((r_) - MTOK) * DM) + lane; \
            _Pragma("unroll") for (int j = 0; j < 8; ++j) dst_[j] = xr_[64 * j]; } } while (0)
          int m1 = next_row(m);
          P0_LOADROW(v, m); P0_LOADROW(vn, m1);
          while (m < ROWS_END) {
            const int m2 = next_row(m1);
            P0_LOADROW(vnn, m2);
            float ss = 0.f;
#pragma unroll
            for (int j = 0; j < 8; ++j) ss += (v[j].x * v[j].x + v[j].y * v[j].y) + (v[j].z * v[j].z + v[j].w * v[j].w);
            const float rstd = rsqrtf(wave_sum(ss) * (1.f / DM) + RMS_EPS);
            float ff[8];
#pragma unroll
            for (int h = 0; h < 8; ++h) ff[h] = 0.f;
            GAS v2u* o8 = (GAS v2u*)(XN + (size_t)m * DM) + lane;
#pragma unroll
            for (int j = 0; j < 8; ++j) { const f32x4 yv = v[j] * rstd * gA[j];
                v2u w; w.x = pg8::cvt_pk_bf16(yv.x, yv.y); w.y = pg8::cvt_pk_bf16(yv.z, yv.w); o8[64 * j] = w;
#pragma unroll
                for (int h = 0; h < 8; ++h) { const f32x4 w4 = *(const LAS f32x4*)(wff + h * DM + 256 * j + 4 * lane); ff[h] += (yv.x * w4.x + yv.y * w4.y) + (yv.z * w4.z + yv.w * w4.w); }
                asm volatile("" ::: "memory"); }
            float r4[4], r2[2], r1;
            { const bool b0 = lane & 1;
#pragma unroll
              for (int i = 0; i < 4; ++i) { const float keep = b0 ? ff[2 * i + 1] : ff[2 * i], send = b0 ? ff[2 * i] : ff[2 * i + 1]; r4[i] = keep + __shfl_xor(send, 1); }
              const bool b1 = lane & 2;
#pragma unroll
              for (int i = 0; i < 2; ++i) { const float keep = b1 ? r4[2 * i + 1] : r4[2 * i], send = b1 ? r4[2 * i] : r4[2 * i + 1]; r2[i] = keep + __shfl_xor(send, 2); }
              const bool b2 = lane & 4; const float keep = b2 ? r2[1] : r2[0], send = b2 ? r2[0] : r2[1]; r1 = keep + __shfl_xor(send, 4);
              r1 += __shfl_xor(r1, 8); r1 += __shfl_xor(r1, 16); r1 += __shfl_xor(r1, 32); }
            if (lane < 8) { const float lf = log_sigmoid(r1 + ffbv); if (m < MTOK) LOGF[(size_t)m * 8 + lane] = lf; else LOGFM[(m - MTOK) * 8 + lane] = lf; }
#pragma unroll
            for (int j = 0; j < 8; ++j) { v[j] = vn[j]; vn[j] = vnn[j]; }
            m = m1; m1 = m2; } }
#undef P0_LOADROW
        if (vcu == G - 1) {
            { const int i = tid, h = i >> 7, d = i & 127; int bk;
                if (d < 16) bk = d; else { const float lp = logf((float)d / 16.0f) / 2.0794415416798357f; bk = 16 + (int)(lp * 16.0f); bk = bk > 31 ? 31 : bk; }
                TAB[i] = relb[bk * 4 + h] * LOG2E; }
          if (wave == 0) {
            float s1 = lq1[lane] * lk1[lane] + lq1[lane + 64] * lk1[lane + 64], s2 = lq2[lane] * lk2[lane] + lq2[lane + 64] * lk2[lane + 64];
            s1 = wave_sum(s1); s2 = wave_sum(s2);
            if (lane == 0) LAMP[0] = expf(s1) - expf(s2) + LAMBDA_INIT; }
        }
        for (int i = gw; i < 4 * NB * 48; i += NGW) { const int bufi = i / (NB * 48), rr = i % (NB * 48), b = rr / 48, kv = 16 + rr % 48;
            bf16* base = bufi == 0 ? KF : bufi == 1 ? VF : bufi == 2 ? KD : VD; GAS v4u* p = (GAS v4u*)(base + (size_t)(b * KVB + kv) * 1024);
            p[lane] = (v4u){0u, 0u, 0u, 0u}; p[lane + 64] = (v4u){0u, 0u, 0u, 0u}; }
    }
    SEAM(0);

    if (IN(1)) for (int rep_ = 0; rep_ < REPS(1); ++rep_) { if (rep_) xcd_barrier(bar);
        int tid_o = threadIdx.x; asm volatile("" : "+v"(tid_o)); const int tid = tid_o, lane = tid_o & 63;
        for (int job = bx; job < 96; job += G) {
            if (job < 64) {
                const int q0 = 64 * job; f32x4 acc[4];
#pragma unroll
                for (int nb = 0; nb < 4; ++nb) acc[nb] = (f32x4){0.f, 0.f, 0.f, 0.f};
                const bf16* ap = XN + (size_t)(MTOK + (lane & 15)) * DM + 256 * wave + 8 * (lane >> 4);
#pragma unroll
                for (int st = 0; st < 8; ++st) { const bf16x8 a = *(const bf16x8*)(ap + 32 * st);
#pragma unroll
                    for (int nb = 0; nb < 4; ++nb) { const int q = q0 + 16 * nb + (lane & 15); const int wrow = q < 2048 ? 1024 + q : 2048 + q;
                        const bf16x8 bq = *(const bf16x8*)(WIN + (size_t)wrow * DM + 256 * wave + 32 * st + 8 * (lane >> 4));
                        acc[nb] = __builtin_amdgcn_mfma_f32_16x16x32_bf16(a, bq, acc[nb], 0, 0, 0); } }
                LAS float* part = (LAS float*)(lds + RING_OFF);
#pragma unroll
                for (int nb = 0; nb < 4; ++nb)
#pragma unroll
                    for (int r = 0; r < 4; ++r) part[(wave * 16 + (lane >> 4) * 4 + r) * 64 + 16 * nb + (lane & 15)] = acc[nb][r];
                __syncthreads();
                for (int idx = tid; idx < 1024; idx += NWAVES * 64) { const int row = idx >> 6, col = idx & 63; float s = 0.f;
#pragma unroll
                    for (int w = 0; w < 8; ++w) s += part[(w * 16 + row) * 64 + col];
                    const int q = q0 + col; bf16* base = q < 1024 ? KF : q < 2048 ? VF : q < 3072 ? KD : VD; const bf16 hv = (bf16)f2bf(s);
#pragma unroll
                    for (int b = 0; b < NB; ++b) base[(size_t)(b * KVB + row) * 1024 + (q & 1023)] = hv; }
                __syncthreads();
            } else if (wave == 0) {
                const int b = (job - 64) >> 3, h = (job - 64) & 7; float* nbp = NBIAS + (size_t)(b * 8 + h) * KVB; float v[33];
#pragma unroll
                for (int ch = 0; ch < 33; ++ch) { const int p = 64 * ch + lane; v[ch] = 0.f;
                    if (p < NMETA) v[ch] = LOGFM[p * 8 + h]; else if (p < NMETA + SEQ) v[ch] = LOGF[(size_t)(b * SEQ + p - NMETA) * 8 + h]; }
                float carry = 0.f;
#pragma unroll
                for (int ch = 0; ch < 33; ++ch) { const int p = 64 * ch + lane; float x = v[ch];
#pragma unroll
                    for (int o = 1; o < 64; o <<= 1) { const float t = __shfl_up(x, o); if (lane >= o) x += t; }
                    x += carry;
                    if (p < NMETA + SEQ) nbp[p < NMETA ? p : p + 48] = -x * LOG2E;
                    carry = __shfl(x, 63); }
                if (lane >= 16) nbp[lane] = 0.f;
            }
        }
        __syncthreads();
        pg8::Gemm g{XN, WIN, MTOK, NPROJ, DM}; pg8::StaticOrder S; S.init(MTOK, NPROJ, G, bx);
        pg8::EpiInProj E{QF, KF, VF, QD, KD, VD, GF, GD, QSCALE};
        pg8::BgW bgw{w_gu, w_dn, WGU8, WD8, bx, 1024 * att::BG_E0 + 16384, G, -1, pg8::W8_SCALE, 1024 * att::BG_E0, pg8::BGW_GU - 1024 * att::BG_E0};
        pg8::gemm_phase<pg8::EpiInProj, pg8::StaticOrder, true, true, false, 0>(lds + RING_OFF, g, S, E, &bgw);
    }
    SEAM(1);

    if (IN(2)) for (int rep_ = 0; rep_ < REPS(2); ++rep_) { if (rep_) xcd_barrier(bar);
        int tid_o = threadIdx.x; asm volatile("" : "+v"(tid_o)); const int tid = tid_o, lane = tid_o & 63;
        LAS int* qslot = (LAS int*)(lds + RING_OFF + att::L_Q);
        att::Bg bg; { const int total = (NEXP - att::BG_E0) * att::BG_PER_E, per = (total + G - 1) / G; bg.w = w_gu; bg.w8 = WGU8; bg.pos = bx * per; bg.end = (bx * per + per < total) ? bx * per + per : total; bg.scale = pg8::W8_SCALE; if (rep_) bg.end = bg.pos; }
        for (;;) {
            if (tid == 0) *qslot = (int)__hip_atomic_fetch_add(ctl + CW_AQ + 64 * rep_, 1u, RLX_AGENT);
            __syncthreads();
            const int u = __builtin_amdgcn_readfirstlane(*qslot);
            __syncthreads();
            if (u >= 768) break;
            const int qb = 7 - u / 96, rem = u % 96, jb = rem >> 2, b = rem & 3;
            att::Job J;
            if (jb < 8) { J.Q = QF + jb * 128; J.K = KF + jb * 128; J.V = VF + jb * 128; J.O = OFOX + jb * 128; J.nb = NBIAS + (size_t)jb * KVB; J.tab = TAB; J.fox = 1; }
            else { const int d = jb - 8, h = d >> 2, mp = (d >> 1) & 1, vh = d & 1;
                J.Q = QD + h * 256 + mp * 128; J.K = KD + h * 256 + mp * 128; J.V = VD + h * 256 + vh * 128; J.O = (mp ? AD1 : AD0) + h * 256 + vh * 128; J.nb = NBIAS; J.tab = TAB + h * 128; J.fox = 0; }
            if (jb < 8) J.nb += (size_t)b * 7 * KVB;
            att::attn_unit((LAS char*)(lds + RING_OFF), J, b, qb, bg);
        }
        while (bg.pos < bg.end) { att::bg_issue(bg, (LAS char*)(lds + RING_OFF), wave, lane); att::bg_consume(bg, (LAS char*)(lds + RING_OFF), wave, lane); ++bg.pos; asm volatile("s_waitcnt lgkmcnt(0)" ::: "memory"); }
    }
    SEAM(2);

    if (IN(3)) for (int rep_ = 0; rep_ < REPS(3); ++rep_) { if (rep_) xcd_barrier(bar);
        int tid_o = threadIdx.x; asm volatile("" : "+v"(tid_o)); const int tid = tid_o, lane = tid_o & 63;
        const float lam = LAMP[0];
        const int sub = lane & 15;
        f32x4 sl[4];
#pragma unroll
        for (int i = 0; i < 4; ++i) sl[i] = *(const f32x4*)(subln + sub * 16 + 4 * i);
        for (int m = gw; m < MTOK; m += NGW) {
            const size_t off = (size_t)m * 1024 + lane * 16;
            const v4u a0 = *(const GAS v4u*)(AD0 + off), a1 = *(const GAS v4u*)(AD0 + off + 8), c0 = *(const GAS v4u*)(AD1 + off), c1 = *(const GAS v4u*)(AD1 + off + 8);
            float a[16];
#pragma unroll
            for (int i = 0; i < 4; ++i) { a[2 * i] = bflo(a0[i]) - lam * bflo(c0[i]); a[2 * i + 1] = bfhi(a0[i]) - lam * bfhi(c0[i]); a[8 + 2 * i] = bflo(a1[i]) - lam * bflo(c1[i]); a[8 + 2 * i + 1] = bfhi(a1[i]) - lam * bfhi(c1[i]); }
            float ss = 0.f;
#pragma unroll
            for (int i = 0; i < 16; ++i) ss += a[i] * a[i];
            ss += __shfl_xor(ss, 1); ss += __shfl_xor(ss, 2); ss += __shfl_xor(ss, 4); ss += __shfl_xor(ss, 8);
            const float rs = rsqrtf(ss * (1.f / 256.f) + RMS_EPS) * (1.0f - LAMBDA_INIT);
            v4u o0, o1;
#pragma unroll
            for (int i = 0; i < 4; ++i) { o0[i] = pk2(a[2 * i] * rs * sl[i >> 1][(2 * i) & 3], a[2 * i + 1] * rs * sl[i >> 1][(2 * i + 1) & 3]);
                                          o1[i] = pk2(a[8 + 2 * i] * rs * sl[2 + (i >> 1)][(2 * i) & 3], a[8 + 2 * i + 1] * rs * sl[2 + (i >> 1)][(2 * i + 1) & 3]); }
            *(GAS v4u*)(ODIFF + off) = o0; *(GAS v4u*)(ODIFF + off + 8) = o1;
        }
    }
    SEAM(3);

    if (IN(4)) for (int rep_ = 0; rep_ < REPS(4); ++rep_) { if (rep_) xcd_barrier(bar);
        int tid_o = threadIdx.x; asm volatile("" : "+v"(tid_o)); const int tid = tid_o, lane = tid_o & 63;
        pg8::Gemm g{OFOX, WBF, 2 * MTOK, 2 * DM, 1024}; pg8::PairOrder S; S.S.init(MTOK, DM, G, bx);
        pg8::EpiGate2 E{GF, GD, T1, MERGED};
        pg8::gemm_phase<pg8::EpiGate2, pg8::PairOrder, true, true>(lds + RING_OFF, g, S, E);
    }
    SEAM(4);
    if (IN(5)) { }
    if (IN(6)) for (int rep_ = 0; rep_ < REPS(6); ++rep_) { if (rep_) xcd_barrier(bar);
        int tid_o = threadIdx.x; asm volatile("" : "+v"(tid_o)); const int tid = tid_o, lane = tid_o & 63;
        pg8::Gemm g{MERGED, WOUT, MTOK, DM, DM}; pg8::StaticOrder S; S.init(MTOK, DM, G, bx);
        pg8::EpiResF32 E{x, H1};
        pg8::gemm_phase<pg8::EpiResF32, pg8::StaticOrder, true, true>(lds + RING_OFF, g, S, E);
    }
    SEAM(6);

    if (IN(7)) for (int rep_ = 0; rep_ < REPS(7); ++rep_) { if (rep_) xcd_barrier(bar);
        int tid_o = threadIdx.x; asm volatile("" : "+v"(tid_o)); const int tid = tid_o, lane = tid_o & 63;
        LAS float* part = (LAS float*)(lds + RING_OFF);
        LAS float* lg = (LAS float*)(lds + RING_OFF + 32768);
        LAS float* rs = (LAS float*)(lds + RING_OFF + 40960);
        LAS int* hist = (LAS int*)(lds + RING_OFF + 41216);
        LAS int* gbase = (LAS int*)(lds + RING_OFF + 41472);
        LAS int* sel = (LAS int*)(lds + RING_OFF + 41728);
        LAS int* lrank = (LAS int*)(lds + RING_OFF + 42240);
        for (int it = bx; it < MTOK / 32; it += G) {
            const int t0 = 32 * it;
            if (tid < 32) hist[tid] = 0;
            LAS unsigned* xst = (LAS unsigned*)(lds + RING_OFF + 49152);
            { f32x4 v[8], vn[8];
              { const GAS f32x4* xr = (const GAS f32x4*)(H1 + (size_t)(t0 + 4 * wave) * DM) + lane;
#pragma unroll
                for (int j = 0; j < 8; ++j) v[j] = xr[64 * j]; }
#pragma unroll 1
              for (int i = 0; i < 4; ++i) {
                if (i < 3) { const GAS f32x4* xr = (const GAS f32x4*)(H1 + (size_t)(t0 + 4 * wave + i + 1) * DM) + lane;
#pragma unroll
                    for (int j = 0; j < 8; ++j) vn[j] = xr[64 * j]; }
                float ss = 0.f;
#pragma unroll
                for (int j = 0; j < 8; ++j) ss += (v[j].x * v[j].x + v[j].y * v[j].y) + (v[j].z * v[j].z + v[j].w * v[j].w);
                const float rstd = rsqrtf(wave_sum(ss) * (1.f / DM) + RMS_EPS);
                LAS unsigned* xw = xst + (4 * wave + i) * 512 + lane;
#pragma unroll
                for (int j = 0; j < 8; ++j) { const f32x4 g = *((const GAS f32x4*)g_ffn + 64 * j + lane); const f32x4 yv = v[j] * (rstd * pg8::X8_SCALE) * g; xw[64 * j] = pg8::pk4_fp8(yv.x, yv.y, yv.z, yv.w); }
                if (lane == 0) rs[4 * wave + i] = rstd;
#pragma unroll
                for (int j = 0; j < 8; ++j) v[j] = vn[j]; } }
            { f32x16 acc;
#pragma unroll
              for (int r = 0; r < 16; ++r) acc[r] = 0.f;
              const int kk = lane >> 5, col = lane & 31; const float* ap = H1 + (size_t)(t0 + col) * DM + 256 * wave + kk; const float* bp = w_router + (size_t)(256 * wave + kk) * NEXP + col; const float* gp = g_ffn + 256 * wave + kk;
#pragma unroll 8
              for (int s = 0; s < 128; ++s) { const float a = ap[2 * s]; const float bw = bp[(size_t)2 * s * NEXP] * gp[2 * s]; acc = __builtin_amdgcn_mfma_f32_32x32x2f32(a, bw, acc, 0, 0, 0); }
#pragma unroll
              for (int r = 0; r < 16; ++r) part[(wave * 32 + ((r & 3) + 8 * (r >> 2) + 4 * kk)) * 32 + col] = acc[r]; }
            __syncthreads();
            for (int idx = tid; idx < 1024; idx += NWAVES * 64) { const int tok = idx >> 5, e = idx & 31; float s = 0.f;
#pragma unroll
                for (int w = 0; w < 8; ++w) s += part[(w * 32 + tok) * 32 + e];
                lg[tok * 33 + e] = s * rs[tok] + b_router[e]; }
            __syncthreads();
            if (tid < 32) { const int tok = tid; float v[4]; int ix[4]; unsigned used = 0u;
#pragma unroll
                for (int k = 0; k < 4; ++k) { float best = -__builtin_inff(); int bi = 0;
                    for (int e = 0; e < NEXP; ++e) { const float z = lg[tok * 33 + e]; if (!((used >> e) & 1u) && z > best) { best = z; bi = e; } }
                    used |= 1u << bi; v[k] = best; ix[k] = bi; }
                const float e1 = expf(v[1] - v[0]), e2 = expf(v[2] - v[0]), e3 = expf(v[3] - v[0]); const float inv = 1.0f / (1.0f + e1 + e2 + e3);
                const float gt[4] = {inv, e1 * inv, e2 * inv, e3 * inv};
#pragma unroll
                for (int k = 0; k < 4; ++k) { TOPI[(size_t)(t0 + tok) * 4 + k] = ix[k]; GATE[(size_t)(t0 + tok) * 4 + k] = gt[k]; sel[tok * 4 + k] = ix[k]; lrank[tok * 4 + k] = __hip_atomic_fetch_add(hist + ix[k], 1, __ATOMIC_RELAXED, __HIP_MEMORY_SCOPE_WORKGROUP); } }
            __syncthreads();
            if (tid < 32) { const int c = hist[tid]; gbase[tid] = c ? (int)__hip_atomic_fetch_add(ctl + CW_CNT + 32 * tid, (unsigned)c, RLX_AGENT) : 0; }
            __syncthreads();
            if (tid < 128) RANK[(size_t)t0 * 4 + tid] = gbase[sel[tid]] + lrank[tid];
            if (tid < 128) ROWTOK[(size_t)sel[tid] * ECAP + gbase[sel[tid]] + lrank[tid]] = t0 + (tid >> 2);
#pragma unroll 1
            for (int i = 0; i < 4; ++i) { const LAS v4u* xs = (const LAS v4u*)(xst + (4 * wave + i) * 512) + lane; const v4u a = xs[0], b = xs[64];
                GAS v4u* o = (GAS v4u*)(XS8 + (size_t)(t0 + 4 * wave + i) * DM) + lane; o[0] = a; o[64] = b; }
            __syncthreads();
        }
    }
    SEAM(7);

    if (IN(8)) { }

    if (IN(9)) for (int rep_ = 0; rep_ < REPS(9); ++rep_) { if (rep_) xcd_barrier(bar);
        int tid_o = threadIdx.x; asm volatile("" : "+v"(tid_o)); const int tid = tid_o, lane = tid_o & 63;
        moe_tables(mt, ctl, tid);
        const int n = moe_build_list(mt, 16, G, bx, tid);
        LAS int* tokl = (LAS int*)(lds + MOE_OFF + 2048);
        for (int idx = tid; idx < 256 * n; idx += NWAVES * 64) { const int ui = idx >> 8, r = idx & 255; const int rr = 128 * mt[72 + 2 * ui] + r, e = (mt[72 + 2 * ui + 1] & 0xffff) >> 4;
            const int tok = (rr - e * ECAP < mt[128 + e]) ? ROWTOK[rr] : 0; tokl[idx] = tok * DM; }
        __syncthreads();
        pg8::Gemm g{(const bf16*)XS8, (const bf16*)WGU8, 0, 0, DM / 2}; pg8::ListOrder S{(const LAS int*)(mt + 72), n, tokl};
        pg8::EpiSwiglu E{b_gu, ACT8};
        pg8::gemm_phase<pg8::EpiSwiglu, pg8::ListOrder, true, true, true, -1, true>(lds + RING_OFF, g, S, E);
    }
    SEAM(9);
    if (IN(10)) for (int rep_ = 0; rep_ < REPS(10); ++rep_) { if (rep_) xcd_barrier(bar);
        int tid_o = threadIdx.x; asm volatile("" : "+v"(tid_o)); const int tid = tid_o, lane = tid_o & 63;
        moe_tables(mt, ctl, tid);
        const int n = moe_build_list(mt, 8, G, bx, tid);
        pg8::Gemm g{(const bf16*)ACT8, (const bf16*)WD8, 0, 0, DM / 2}; pg8::ListOrder S{(const LAS int*)(mt + 72), n};
        pg8::EpiDown E{b_dn, YS};
        pg8::gemm_phase<pg8::EpiDown, pg8::ListOrder, true, true, true>(lds + RING_OFF, g, S, E);
    }
    SEAM(10);

    if (IN(11)) for (int rep_ = 0; rep_ < REPS(11); ++rep_) { if (rep_) xcd_barrier(bar);
        int tid_o = threadIdx.x; asm volatile("" : "+v"(tid_o)); const int tid = tid_o, lane = tid_o & 63;
        { int m = gw; f32x4 v[8], vn[8]; int dst[4], dstn[4]; float gt[4], gtn[4];
#define P11_FETCH(mm_, vv_, dd_, gg_) do { const GAS f32x4* hr_ = (const GAS f32x4*)(H1 + (size_t)(mm_) * DM) + lane; \
            _Pragma("unroll") for (int j = 0; j < 8; ++j) vv_[j] = hr_[64 * j]; \
            _Pragma("unroll") for (int k = 0; k < 4; ++k) { dd_[k] = __builtin_amdgcn_readfirstlane(TOPI[(size_t)(mm_) * 4 + k]) * ECAP + __builtin_amdgcn_readfirstlane(RANK[(size_t)(mm_) * 4 + k]); gg_[k] = GATE[(size_t)(mm_) * 4 + k]; } } while (0)
          if (m < MTOK) P11_FETCH(m, v, dst, gt);
          while (m < MTOK) {
            const int mn = m + NGW;
            unsigned ys[4][8];
#pragma unroll
            for (int k = 0; k < 4; ++k) { const GAS unsigned* yr = (const GAS unsigned*)(YS + (size_t)dst[k] * DM) + lane;
#pragma unroll
                for (int j = 0; j < 8; ++j) ys[k][j] = yr[64 * j]; }
            if (mn < MTOK) P11_FETCH(mn, vn, dstn, gtn);
#pragma unroll
            for (int k = 0; k < 4; ++k)
#pragma unroll
                for (int j = 0; j < 8; ++j) { const unsigned w = ys[k][j]; const auto lo = __builtin_amdgcn_cvt_pk_f32_fp8(w, false), hi2 = __builtin_amdgcn_cvt_pk_f32_fp8(w, true); const float gk = gt[k] * (1.0f / pg8::Y8_SCALE);
                    v[j].x += gk * lo[0]; v[j].y += gk * lo[1]; v[j].z += gk * hi2[0]; v[j].w += gk * hi2[1]; }
            float ss = 0.f;
#pragma unroll
            for (int j = 0; j < 8; ++j) ss += (v[j].x * v[j].x + v[j].y * v[j].y) + (v[j].z * v[j].z + v[j].w * v[j].w);
            const float rstd = rsqrtf(wave_sum(ss) * (1.f / DM) + RMS_EPS);
            GAS f32x4* orow = (GAS f32x4*)(args.out + (size_t)m * DM) + lane;
#pragma unroll
            for (int j = 0; j < 8; ++j) { const f32x4 g = *((const GAS f32x4*)g_fin + 64 * j + lane); orow[64 * j] = v[j] * rstd * g; }
#pragma unroll
            for (int j = 0; j < 8; ++j) v[j] = vn[j];
#pragma unroll
            for (int k = 0; k < 4; ++k) { dst[k] = dstn[k]; gt[k] = gtn[k]; }
            m = mn; }
#undef P11_FETCH
        }
    }
#undef IN
#undef SEAM
}

extern "C" void kernel_launch(void* const* d_in, const int* in_sizes, int n_in, void* d_out, int out_size, void* d_ws, size_t ws_size, hipStream_t stream) {
    static int grid = 0;
    if (grid == 0) {
        if (n_in != 22 || in_sizes[0] != MTOK * DM || out_size != MTOK * DM || ws_size < WS_END) { fprintf(stderr, "kernel_launch: unexpected shapes (n_in %d, in0 %d, out %d, ws %zu); nothing launched\n", n_in, n_in > 0 ? in_sizes[0] : -1, out_size, ws_size); grid = -1; return; }
        int dev = 0, cus = 0, per_cu = 0;
        if (hipGetDevice(&dev) != hipSuccess || hipDeviceGetAttribute(&cus, hipDeviceAttributeMultiprocessorCount, dev) != hipSuccess) { fprintf(stderr, "kernel_launch: device query failed\n"); grid = -1; return; }
        if (hipFuncSetAttribute((const void*)hyb_fwd, hipFuncAttributeMaxDynamicSharedMemorySize, LDS_BYTES) != hipSuccess) { fprintf(stderr, "kernel_launch: hipFuncSetAttribute failed\n"); grid = -1; return; }
        if (hipOccupancyMaxActiveBlocksPerMultiprocessor(&per_cu, (const void*)hyb_fwd, NWAVES * 64, LDS_BYTES) != hipSuccess || per_cu < 1) fprintf(stderr, "kernel_launch: note: occupancy query reports %d workgroups per CU\n", per_cu);
        (void)hipGetLastError();
        grid = cus;
    }
    if (grid < 0) return;
    if (hipMemsetAsync((char*)d_ws + WS_CTL, 0, CTL_ZERO_BYTES, stream) != hipSuccess) { fprintf(stderr, "kernel_launch: memset failed\n"); return; }
    Args a{};
    for (int i = 0; i < 22; ++i) a.in[i] = (const float*)d_in[i];
    a.out = (float*)d_out; a.ws = (unsigned char*)d_ws;
#if MK_N_LAUNCHES == 1
    a.ph_lo = 0; a.ph_hi = NPHASE;
    hipLaunchKernelGGL(hyb_fwd, dim3(grid), dim3(NWAVES * 64), LDS_BYTES, stream, a);
#else
    for (int p = 0; p < NPHASE; ++p) { a.ph_lo = p; a.ph_hi = p + 1; hipLaunchKernelGGL(hyb_fwd, dim3(grid), dim3(NWAVES * 64), LDS_BYTES, stream, a); }
#endif
    const hipError_t le = hipPeekAtLastError();
    if (le != hipSuccess) fprintf(stderr, "kernel_launch: launch failed: %s\n", hipGetErrorName(le));
}
```
